# Optimizing an MI355X kernel written in HIP

```python
import jax
import jax.numpy as jnp
from jax import lax
import numpy as np

D_MODEL = 1024
BATCH = 8
SEQ = 2048
DEPTH = 2

GRID_W = 64
CTX_LEN = 256
HEAD_DIM = 64
H_ATT = 6
H_KV = 2
H_RET = 4
H_SSD = 6
SSD_GROUPS = 2
SSD_STATE = 128
SSD_CONV = 5
D_ATT = H_ATT * HEAD_DIM
D_KV = H_KV * HEAD_DIM
D_RET = H_RET * HEAD_DIM
D_SSD = H_SSD * HEAD_DIM
D_XBC = D_SSD + 2 * SSD_GROUPS * SSD_STATE
D_MIX = D_ATT + D_RET + D_SSD
D_FF = 4 * D_MODEL
IN_SPLITS = (D_ATT, D_KV, D_KV, D_RET, D_RET, D_RET, D_RET, D_SSD, D_XBC, 2 * H_SSD)
D_IN = sum(IN_SPLITS)
Q_BLOCK = 128
CHUNK = 128
ROPE_THETA = 10000.0
EPS = 1e-6
F32 = jnp.float32

kernel_name = 'hybrid_parallel_heads_dit_block'


def rmsnorm(x, g):
    xf = x.astype(F32)
    y = xf * lax.rsqrt(jnp.mean(xf * xf, axis=-1, keepdims=True) + EPS)
    return (y * g.astype(F32)).astype(x.dtype)


def grid_rope(n):
    rows = n // GRID_W
    row = jnp.broadcast_to(jnp.arange(rows)[:, None], (rows, GRID_W)).reshape(n)
    col = jnp.broadcast_to(jnp.arange(GRID_W)[None, :], (rows, GRID_W)).reshape(n)
    half = HEAD_DIM // 2
    inv_freq = ROPE_THETA ** (-jnp.arange(0, half, 2, dtype=F32) / half)
    ang = jnp.stack([row, col], axis=-1).astype(F32)[:, :, None] * inv_freq
    ang = jnp.concatenate([ang, ang], axis=-1)
    return jnp.cos(ang), jnp.sin(ang)


def apply_rope(x, cos, sin):
    b, n, h, d = x.shape
    xr = x.astype(F32).reshape(b, n, h, 2, d // 2)
    x1, x2 = jnp.split(xr, 2, axis=-1)
    rot = jnp.concatenate([-x2, x1], axis=-1)
    out = xr * cos[:, None] + rot * sin[:, None]
    return out.reshape(b, n, h, d).astype(x.dtype)


def depthwise_conv(x, w, b):
    y = lax.conv_general_dilated(x, w[:, None, :].astype(x.dtype), window_strides=(1,),
                                 padding=[(SSD_CONV // 2, SSD_CONV // 2)],
                                 dimension_numbers=('NWC', 'WIO', 'NWC'),
                                 feature_group_count=x.shape[-1])
    return y + b.astype(x.dtype)


def chunked_recurrence(q, k, v, log_a, s0, strict):
    b, h, l, n = q.shape
    p = v.shape[-1]
    nc = l // CHUNK
    qc = q.astype(F32).reshape(b, h, nc, CHUNK, n)
    kc = k.astype(F32).reshape(b, h, nc, CHUNK, n)
    vc = v.astype(F32).reshape(b, h, nc, CHUNK, p)
    cum = jnp.cumsum(log_a.astype(F32).reshape(b, h, nc, CHUNK), axis=-1)
    idx = jnp.arange(CHUNK)
    mask = (idx[:, None] > idx[None, :]) if strict else (idx[:, None] >= idx[None, :])
    decay = jnp.exp(jnp.where(mask, cum[..., :, None] - cum[..., None, :], -jnp.inf))
    scores = jnp.einsum('bhcin,bhcjn->bhcij', qc, kc) * decay
    y_intra = jnp.einsum('bhcij,bhcjp->bhcip', scores, vc)
    last = cum[..., -1:]
    d_state = jnp.einsum('bhcj,bhcjn,bhcjp->bhcnp', jnp.exp(last - cum), kc, vc)
    chunk_decay = jnp.exp(last[..., 0])

    def step(s, inp):
        dec, ds = inp
        return dec[..., None, None] * s + ds, s

    s_final, s_in = lax.scan(step, s0.astype(F32),
                             (jnp.moveaxis(chunk_decay, 2, 0), jnp.moveaxis(d_state, 2, 0)))
    s_in = jnp.moveaxis(s_in, 0, 2)
    y_inter = jnp.exp(cum)[..., None] * jnp.einsum('bhcin,bhcnp->bhcip', qc, s_in)
    return (y_intra + y_inter).reshape(b, h, l, p), s_final


def final_state(k, v, log_a):
    cum = jnp.cumsum(log_a.astype(F32), axis=-1)
    w = jnp.exp(cum[..., -1:] - cum)
    return jnp.einsum('bhl,bhln,bhlp->bhnp', w, k.astype(F32), v.astype(F32))


def bidirectional_recurrence(q, ks, v, las, qc, kcs, vc, lacs, need_ctx_out):
    bsz, h, _, n_state = q.shape
    p = v.shape[-1]
    y_dirs = []
    yc_dirs = []
    for direction in range(2):
        rev = direction == 1
        fl = (lambda t: jnp.flip(t, axis=2)) if rev else (lambda t: t)
        if need_ctx_out:
            yc_d, s_ctx = chunked_recurrence(fl(qc), fl(kcs[direction]), fl(vc), fl(lacs[direction]),
                                             jnp.zeros((bsz, h, n_state, p), F32), rev)
            yc_dirs.append(fl(yc_d))
        else:
            s_ctx = final_state(fl(kcs[direction]), fl(vc), fl(lacs[direction]))
        y_d, _ = chunked_recurrence(fl(q), fl(ks[direction]), fl(v), fl(las[direction]), s_ctx, rev)
        y_dirs.append(fl(y_d))
    y = (y_dirs[0] + y_dirs[1]).astype(v.dtype)
    if not need_ctx_out:
        return y, None
    return y, (yc_dirs[0] + yc_dirs[1]).astype(vc.dtype)


def sdpa(qh, keys, vals):
    b, lq = qh.shape[:2]
    qg = qh.reshape(b, lq, H_KV, H_ATT // H_KV, HEAD_DIM)
    s = jnp.einsum('bqkgd,bskd->bkgqs', qg, keys).astype(F32) * (HEAD_DIM ** -0.5)
    pr = jax.nn.softmax(s, axis=-1).astype(vals.dtype)
    o = jnp.einsum('bkgqs,bskd->bqkgd', pr, vals)
    return o.reshape(b, lq, D_ATT)


def attention_mixer(q, k, v, qc, kc, vc, qn_g, kn_g, cos, sin, need_ctx_out):
    b, n, _ = q.shape
    lc = kc.shape[1]
    q = apply_rope(rmsnorm(q.reshape(b, n, H_ATT, HEAD_DIM), qn_g), cos, sin)
    k = apply_rope(rmsnorm(k.reshape(b, n, H_KV, HEAD_DIM), kn_g), cos, sin)
    kc = rmsnorm(kc.reshape(b, lc, H_KV, HEAD_DIM), kn_g)
    vc = vc.reshape(b, lc, H_KV, HEAD_DIM)
    keys = jnp.concatenate([k, kc], axis=1)
    vals = jnp.concatenate([v.reshape(b, n, H_KV, HEAD_DIM), vc], axis=1)
    nb = n // Q_BLOCK
    q_blocks = jnp.moveaxis(q.reshape(b, nb, Q_BLOCK, H_ATT, HEAD_DIM), 1, 0)
    out = lax.map(lambda qb: sdpa(qb, keys, vals), q_blocks)
    out = jnp.moveaxis(out, 0, 1).reshape(b, n, D_ATT)
    if not need_ctx_out:
        return out, None
    out_c = sdpa(rmsnorm(qc.reshape(b, lc, H_ATT, HEAD_DIM), qn_g), kc, vc)
    return out, out_c


def head_groupnorm(y, gain, bias):
    mu = jnp.mean(y, axis=-1, keepdims=True)
    var = jnp.mean(jnp.square(y - mu), axis=-1, keepdims=True)
    yn = (y - mu) * lax.rsqrt(var + EPS)
    b, h, l, p = y.shape
    yn = jnp.transpose(yn, (0, 2, 1, 3)).reshape(b, l, h * p)
    return yn * gain.astype(F32) + bias.astype(F32)


def retention_mixer(q, k, v, g, qc, kc, vc, gc, decay_logit, gn_g, gn_b, cos, sin, need_ctx_out):
    b, n, _ = q.shape
    lc = qc.shape[1]
    heads = lambda t: t.reshape(t.shape[0], t.shape[1], H_RET, HEAD_DIM)
    bhld = lambda t: jnp.transpose(t, (0, 2, 1, 3))
    kscale = HEAD_DIM ** -0.5
    q = bhld(apply_rope(heads(q), cos, sin))
    k = bhld(apply_rope(heads(k), cos, sin)) * kscale
    v = bhld(heads(v))
    qc = bhld(heads(qc))
    kc = bhld(heads(kc)) * kscale
    vc = bhld(heads(vc))
    log_gamma = jax.nn.log_sigmoid(decay_logit.astype(F32))
    las = tuple(jnp.broadcast_to(log_gamma[d][None, :, None], (b, H_RET, n)) for d in range(2))
    lacs = tuple(jnp.broadcast_to(log_gamma[d][None, :, None], (b, H_RET, lc)) for d in range(2))
    y, yc = bidirectional_recurrence(q, (k, k), v, las, qc, (kc, kc), vc, lacs, need_ctx_out)
    out = (head_groupnorm(y.astype(F32), gn_g, gn_b) * jax.nn.silu(g.astype(F32))).astype(g.dtype)
    if not need_ctx_out:
        return out, None
    out_c = (head_groupnorm(yc.astype(F32), gn_g, gn_b) * jax.nn.silu(gc.astype(F32))).astype(gc.dtype)
    return out, out_c


def ssd_prep(xbc, dt_raw, conv_w, conv_b, dt_bias, a_log):
    b, l, _ = xbc.shape
    xbc = jax.nn.silu(depthwise_conv(xbc, conv_w, conv_b))
    xs, bm, cm = jnp.split(xbc, [D_SSD, D_SSD + SSD_GROUPS * SSD_STATE], axis=-1)
    rep = H_SSD // SSD_GROUPS
    xs = jnp.transpose(xs.reshape(b, l, H_SSD, HEAD_DIM), (0, 2, 1, 3))
    bm = jnp.repeat(jnp.transpose(bm.reshape(b, l, SSD_GROUPS, SSD_STATE), (0, 2, 1, 3)), rep, axis=1)
    cm = jnp.repeat(jnp.transpose(cm.reshape(b, l, SSD_GROUPS, SSD_STATE), (0, 2, 1, 3)), rep, axis=1)
    dt = jax.nn.softplus(dt_raw.astype(F32).reshape(b, l, 2, H_SSD) + dt_bias.astype(F32))
    dt = jnp.transpose(dt, (2, 0, 3, 1))
    a = -jnp.exp(a_log.astype(F32))
    las = tuple(dt[d] * a[d][None, :, None] for d in range(2))
    ks = tuple(bm.astype(F32) * dt[d][..., None] for d in range(2))
    return xs, cm, ks, las


def ssd_finish(y, xs, z, d_skip, norm_g):
    y = y + d_skip.astype(y.dtype)[None, :, None, None] * xs
    b, _, l, _ = y.shape
    y = jnp.transpose(y, (0, 2, 1, 3)).reshape(b, l, D_SSD)
    return rmsnorm(y * jax.nn.silu(z), norm_g)


def ssd_mixer(z, xbc, dt_raw, zc, xbcc, dtc_raw, conv_w, conv_b, dt_bias, a_log, d_skip, norm_g, need_ctx_out):
    xs, cm, ks, las = ssd_prep(xbc, dt_raw, conv_w, conv_b, dt_bias, a_log)
    xsc, cmc, ksc, lasc = ssd_prep(xbcc, dtc_raw, conv_w, conv_b, dt_bias, a_log)
    y, yc = bidirectional_recurrence(cm, ks, xs, las, cmc, ksc, xsc, lasc, need_ctx_out)
    out = ssd_finish(y, xs, z, d_skip, norm_g)
    if not need_ctx_out:
        return out, None
    return out, ssd_finish(yc, xsc, zc, d_skip, norm_g)


def squared_relu_mlp(h, w1, w2):
    return jnp.square(jax.nn.relu(h @ w1)) @ w2


def trunk_layer(x, xc, mod, mod_c, norm_g, w_in, w_out, qn_g, kn_g, ret_decay, ret_gn_g, ret_gn_b,
                conv_w, conv_b, dt_bias, a_log, d_skip, ssd_norm_g, w_ff1, w_ff2, cos, sin, need_ctx_out):
    sh1, sc1, g1, sh2, sc2, g2 = jnp.split(mod, 6, axis=-1)
    csh1, csc1, cg1, csh2, csc2, cg2 = jnp.split(mod_c, 6, axis=-1)
    split_idx = np.cumsum(IN_SPLITS)[:-1].tolist()
    h = rmsnorm(x, norm_g[0]) * (1 + sc1[:, None]) + sh1[:, None]
    hc = rmsnorm(xc, norm_g[0]) * (1 + csc1) + csh1
    qa, ka, va, qr, kr, vr, gr, z, xbc, dt = jnp.split(h @ w_in, split_idx, axis=-1)
    qac, kac, vac, qrc, krc, vrc, grc, zc, xbcc, dtc = jnp.split(hc @ w_in, split_idx, axis=-1)
    att, att_c = attention_mixer(qa, ka, va, qac, kac, vac, qn_g, kn_g, cos, sin, need_ctx_out)
    ret, ret_c = retention_mixer(qr, kr, vr, gr, qrc, krc, vrc, grc, ret_decay, ret_gn_g, ret_gn_b,
                                 cos, sin, need_ctx_out)
    ssd, ssd_c = ssd_mixer(z, xbc, dt, zc, xbcc, dtc, conv_w, conv_b, dt_bias, a_log, d_skip, ssd_norm_g,
                           need_ctx_out)
    o = jnp.concatenate([att, ret, ssd], axis=-1) @ w_out
    x = x + g1[:, None] * rmsnorm(o, norm_g[1])
    h2 = rmsnorm(x, norm_g[2]) * (1 + sc2[:, None]) + sh2[:, None]
    x = x + g2[:, None] * rmsnorm(squared_relu_mlp(h2, w_ff1, w_ff2), norm_g[3])
    if need_ctx_out:
        oc = jnp.concatenate([att_c, ret_c, ssd_c], axis=-1) @ w_out
        xc = xc + cg1 * rmsnorm(oc, norm_g[1])
        h2c = rmsnorm(xc, norm_g[2]) * (1 + csc2) + csh2
        xc = xc + cg2 * rmsnorm(squared_relu_mlp(h2c, w_ff1, w_ff2), norm_g[3])
    return x, xc


def setup_inputs(seed: int = 0) -> dict:
    key = jax.random.key(seed)
    ks = jax.random.split(key, 24)
    nrm = lambda k, shape, s: jax.random.normal(k, shape, F32) * s
    gamma = 1.0 - 2.0 ** (-5.0 - jnp.arange(H_RET, dtype=F32))
    ret_logit = jnp.log(gamma) - jnp.log1p(-gamma)
    dt0 = jnp.exp(jax.random.uniform(ks[15], (DEPTH, 2, H_SSD), F32, jnp.log(1e-3), jnp.log(1e-1)))
    return {
        'x': nrm(ks[0], (BATCH, SEQ, D_MODEL), 1.0),
        'c': nrm(ks[1], (BATCH, D_MODEL), 1.0),
        'ctx': nrm(ks[2], (BATCH, CTX_LEN, D_MODEL), 1.0),
        'c_ctx': nrm(ks[3], (D_MODEL,), 1.0),
        'w_mod': nrm(ks[4], (DEPTH, D_MODEL, 6 * D_MODEL), 0.5 * D_MODEL ** -0.5),
        'b_mod': nrm(ks[5], (DEPTH, 6 * D_MODEL), 0.01),
        'norm_g': 1.0 + nrm(ks[6], (DEPTH, 4, D_MODEL), 0.05),
        'w_in': nrm(ks[7], (DEPTH, D_MODEL, D_IN), D_MODEL ** -0.5),
        'w_out': nrm(ks[8], (DEPTH, D_MIX, D_MODEL), D_MIX ** -0.5),
        'q_norm_g': 1.0 + nrm(ks[9], (DEPTH, HEAD_DIM), 0.05),
        'k_norm_g': 1.0 + nrm(ks[10], (DEPTH, HEAD_DIM), 0.05),
        'ret_decay_logit': ret_logit + nrm(ks[11], (DEPTH, 2, H_RET), 0.05),
        'ret_gn_g': 1.0 + nrm(ks[12], (DEPTH, D_RET), 0.05),
        'ret_gn_b': nrm(ks[13], (DEPTH, D_RET), 0.01),
        'ssd_conv_w': nrm(ks[14], (DEPTH, SSD_CONV, D_XBC), SSD_CONV ** -0.5),
        'ssd_conv_b': nrm(ks[16], (DEPTH, D_XBC), 0.01),
        'ssd_dt_bias': dt0 + jnp.log(-jnp.expm1(-dt0)),
        'ssd_a_log': jnp.log(jax.random.uniform(ks[17], (DEPTH, 2, H_SSD), F32, 1.0, 16.0)),
        'ssd_d': 1.0 + nrm(ks[18], (DEPTH, H_SSD), 0.1),
        'ssd_norm_g': 1.0 + nrm(ks[19], (DEPTH, D_SSD), 0.05),
        'w_ff1': nrm(ks[20], (DEPTH, D_MODEL, D_FF), D_MODEL ** -0.5),
        'w_ff2': nrm(ks[21], (DEPTH, D_FF, D_MODEL), D_FF ** -0.5),
    }


def reference(x, c, ctx, c_ctx, w_mod, b_mod, norm_g, w_in, w_out, q_norm_g, k_norm_g, ret_decay_logit,
              ret_gn_g, ret_gn_b, ssd_conv_w, ssd_conv_b, ssd_dt_bias, ssd_a_log, ssd_d, ssd_norm_g,
              w_ff1, w_ff2):
    n = x.shape[1]
    cos, sin = grid_rope(n)
    sc = jax.nn.silu(c)
    scc = jax.nn.silu(c_ctx)
    xc = ctx
    for layer in range(DEPTH):
        mod = sc @ w_mod[layer] + b_mod[layer]
        mod_c = scc @ w_mod[layer] + b_mod[layer]
        x, xc = trunk_layer(x, xc, mod, mod_c, norm_g[layer], w_in[layer], w_out[layer],
                            q_norm_g[layer], k_norm_g[layer], ret_decay_logit[layer],
                            ret_gn_g[layer], ret_gn_b[layer], ssd_conv_w[layer], ssd_conv_b[layer],
                            ssd_dt_bias[layer], ssd_a_log[layer], ssd_d[layer], ssd_norm_g[layer],
                            w_ff1[layer], w_ff2[layer], cos, sin, layer < DEPTH - 1)
    return x
```

```cpp
#include <hip/hip_runtime.h>
#include <hip/hip_bf16.h>
#include <cstdio>
#include <cstdint>
#ifndef MK_PER_PHASE
#define MK_PER_PHASE 0
#endif
namespace pg8 {
#define PG8_LAS __attribute__((address_space(3)))
typedef unsigned short bf16_t;
typedef short bf16x8 __attribute__((ext_vector_type(8)));
typedef float f32x4 __attribute__((ext_vector_type(4)));
typedef unsigned u32x4 __attribute__((ext_vector_type(4)));
constexpr int BM = 256, BK = 64, HALF = 128, HTB = HALF * BK * 2  , STAGE_BYTES = 8 * HTB, NXCD = 8, WGM = 4;

__host__ __device__ __forceinline__ int lds_byte(int r, int c) { const int st = (r >> 4) * 2 + (c >> 5), rr = r & 15, cc = c & 31, ob = rr * 64 + cc * 2; return st * 1024 + (ob ^ (((ob >> 9) & 1) << 5)); }
__host__ __device__ __forceinline__ void stage_rc(int b, int& R, int& C) { const int st = b / 1024, sb = b % 1024, swz = sb ^ (((sb >> 9) & 1) << 5); R = (st >> 1) * 16 + swz / 64; C = (st & 1) * 32 + (swz % 64) / 2; }
__host__ __device__ __forceinline__ int perm32(int rho) { const int n = rho >> 4, i = rho & 15; return 8 * (i >> 2) + 4 * n + (i & 3); }

struct Unit { int pm, pn, ko, ks, nkt; };
struct Gemm { const bf16_t* A; const bf16_t* Bt; int M, N, K, ld; };

struct StaticOrder {
    int nM, nN, nwg, G, c, nkt;
    __host__ __device__ void init(int M, int N, int G_, int c_, int nkt_) { nM = M / BM; nN = N / BM; nwg = nM * nN; G = G_; c = c_; nkt = nkt_; }
    __host__ __device__ bool next(int i, Unit& u) const {
        const long L = (long)i * G + c; if (L >= nwg) return false;
        int wgid = (int)L; { const int q = nwg / NXCD, r = nwg % NXCD, xcd = wgid % NXCD, off = wgid / NXCD; wgid = (xcd < r ? xcd * (q + 1) : r * (q + 1) + (xcd - r) * q) + off; }
        const int nig = WGM * nN, gid = wgid / nig, fm = gid * WGM, gsz = (nM - fm) < WGM ? (nM - fm) : WGM;
        u.pm = fm + ((wgid % nig) % gsz); u.pn = (wgid % nig) / gsz; u.ko = 0; u.ks = -1; u.nkt = nkt; return true;
    }
    __device__ __forceinline__ void a_ready(const Unit&) const {}
    __device__ __forceinline__ void done(const Unit&) const {}
};

struct SplitKOrder {
    int pm0, npm, nN, nks, kslice, G, c;
    __host__ __device__ void init(int pm0_, int npm_, int nN_, int nks_, int kslice_, int G_, int c_) { pm0 = pm0_; npm = npm_; nN = nN_; nks = nks_; kslice = kslice_; G = G_; c = c_; }
    __host__ __device__ bool next(int i, Unit& u) const {
        const long L = (long)i * G + c; if (L >= (long)npm * nN * nks) return false;
        const int l = (int)L, ks = l / (npm * nN), t = l % (npm * nN);
        u.pn = t / npm; u.pm = pm0 + t % npm; u.ks = ks; u.ko = ks * kslice; u.nkt = kslice / BK; return true;
    }
    __device__ __forceinline__ void a_ready(const Unit&) const {}
    __device__ __forceinline__ void done(const Unit&) const {}
};
struct ComboOrder {
    StaticOrder s; SplitKOrder k; int rs;
    __host__ __device__ void init(const StaticOrder& s_, const SplitKOrder& k_) { s = s_; k = k_; rs = (s.nwg + s.G - 1) / s.G; }
    __host__ __device__ bool next(int i, Unit& u) const { if (i < rs) return s.next(i, u); return k.next(i - rs, u); }
    __device__ __forceinline__ void a_ready(const Unit&) const {}
    __device__ __forceinline__ void done(const Unit&) const {}
};
__device__ __forceinline__ unsigned cvt_pk_bf16(float lo, float hi) { unsigned r; asm volatile("v_cvt_pk_bf16_f32 %0, %1, %2" : "=v"(r) : "v"(lo), "v"(hi)); return r; }
template <int ACT> struct EpiStore {
    static constexpr bool PERM = true, AFTER_DRAIN = false;
    bf16_t* O; int ldc; bf16_t* Os; size_t slab; int row_sub;
    __device__ __forceinline__ void operator()(const f32x4 (&acc)[2][2][4][2], const Unit& u, int wr, int wc, int fr, int fq) const {
        const int row0 = u.pm * BM + wr * 64 + fr - (u.ks < 0 ? 0 : row_sub); const int col0 = u.pn * BM + wc * 32 + 8 * fq; bf16_t* Ob = u.ks < 0 ? O : Os + (size_t)u.ks * slab;
#pragma unroll
        for (int ai = 0; ai < 2; ++ai)
#pragma unroll
            for (int m = 0; m < 4; ++m) { bf16_t* rowp = Ob + (size_t)(row0 + ai * HALF + m * 16) * ldc + col0;
#pragma unroll
                for (int bj = 0; bj < 2; ++bj) { f32x4 v0 = acc[ai][bj][m][0], v1 = acc[ai][bj][m][1];
                    if (ACT == 2) {
#pragma unroll
                        for (int e = 0; e < 4; ++e) { float a = v0[e] > 0.f ? v0[e] : 0.f; v0[e] = a * a; float b = v1[e] > 0.f ? v1[e] : 0.f; v1[e] = b * b; } }
                    u32x4 w; w.x = cvt_pk_bf16(v0[0], v0[1]); w.y = cvt_pk_bf16(v0[2], v0[3]); w.z = cvt_pk_bf16(v1[0], v1[1]); w.w = cvt_pk_bf16(v1[2], v1[3]);
                    *(u32x4*)(rowp + bj * HALF) = w; } }
    }
};
template <class Epi, class Sched, bool ALIGN_EPI = false, bool SP2 = false>
__device__ __forceinline__ void gemm_phase(PG8_LAS unsigned char* lds, const Gemm g, const Sched& S, const Epi& E) {
    const int tid = threadIdx.x, wid = __builtin_amdgcn_readfirstlane(tid >> 6), lane = tid & 63, wr = wid >> 2, wc = wid & 3, fr = lane & 15, fq = lane >> 4;
    const int K = g.ld;
    unsigned voffA[2], voffB[2];
#pragma unroll
    for (int i = 0; i < 2; ++i) { int R, C; stage_rc(tid * 16 + i * 8192, R, C); const int Rb = Epi::PERM ? ((R & ~31) + perm32(R & 31)) : R;
        voffA[i] = (unsigned)(R * K + C) * 2u; voffB[i] = (unsigned)(Rb * K + C) * 2u; }
    const size_t kstep = (size_t)(BK * 2);
    const size_t hstep = (size_t)HALF * K * 2;
    const size_t tstep = 2 * hstep;
    const unsigned ldsw = (unsigned)wid * 1024u;
    const int aoff = lds_byte(wr * 64 + fr, fq * 8), boff = lds_byte(wc * 32 + fr, fq * 8);
#define PG8_SA(b, h) (((b) * 2 + (h)) * HTB)
#define PG8_SB(b, h) ((4 + (b) * 2 + (h)) * HTB)
#define PG8_STAGE(bufoff, gbase, voff) do { _Pragma("unroll") for (int _i = 0; _i < 2; ++_i) \
        __builtin_amdgcn_global_load_lds((const unsigned*)((const char*)(gbase) + (voff)[_i]), (PG8_LAS unsigned*)(lds + (bufoff) + ldsw + _i * 8192), 16, 0, 0); } while (0)
#define PG8_LDA(dst, b, h) do { _Pragma("unroll") for (int m = 0; m < 4; ++m) _Pragma("unroll") for (int k = 0; k < 2; ++k) dst[m][k] = *(const PG8_LAS bf16x8*)(lds + PG8_SA(b, h) + aoff + m * 2048 + k * 1024); } while (0)
#define PG8_LDB(dst, b, h) do { _Pragma("unroll") for (int n = 0; n < 2; ++n) _Pragma("unroll") for (int k = 0; k < 2; ++k) dst[n][k] = *(const PG8_LAS bf16x8*)(lds + PG8_SB(b, h) + boff + n * 2048 + k * 1024); } while (0)
#define PG8_MMA(ai, bj, At, Bt) do { __builtin_amdgcn_s_setprio(1); _Pragma("unroll") for (int m = 0; m < 4; ++m) _Pragma("unroll") for (int n = 0; n < 2; ++n) _Pragma("unroll") for (int k = 0; k < 2; ++k) \
        acc[ai][bj][m][n] = __builtin_amdgcn_mfma_f32_16x16x32_bf16(Bt[n][k], At[m][k], acc[ai][bj][m][n], 0, 0, 0); __builtin_amdgcn_s_setprio(0); } while (0)
#define PG8_WAIT_V(n) asm volatile("s_waitcnt vmcnt(" #n ")" ::: "memory")
#define PG8_WAIT_L(n) asm volatile("s_waitcnt lgkmcnt(" #n ")" ::: "memory")
#define PG8_BAR __builtin_amdgcn_s_barrier()
#define PG8_SCHED __builtin_amdgcn_sched_barrier(0)
    Unit cur, nxt; int ui = 0;
    if (!S.next(0, cur)) return;
    f32x4 acc[2][2][4][2];
#pragma unroll
    for (int a = 0; a < 2; ++a)
#pragma unroll
        for (int b = 0; b < 2; ++b)
#pragma unroll
            for (int m = 0; m < 4; ++m)
#pragma unroll
                for (int n = 0; n < 2; ++n) acc[a][b][m][n] = (f32x4){0.f, 0.f, 0.f, 0.f};
    bf16x8 At[4][2], B0[2][2], B1[2][2];
    const char* cA = (const char*)g.A + (size_t)cur.pm * tstep + (size_t)cur.ko * 2; const char* cB = (const char*)g.Bt + (size_t)cur.pn * tstep + (size_t)cur.ko * 2;
    S.a_ready(cur);
    if constexpr (SP2) {
        PG8_STAGE(PG8_SB(0, 0), cB, voffB); PG8_STAGE(PG8_SB(0, 1), cB + hstep, voffB); PG8_STAGE(PG8_SA(0, 0), cA, voffA); PG8_STAGE(PG8_SA(0, 1), cA + hstep, voffA);
        if (wr == 1) PG8_BAR;
        PG8_WAIT_V(2); PG8_BAR;
        PG8_STAGE(PG8_SB(1, 0), cB + kstep, voffB); PG8_STAGE(PG8_SA(1, 0), cA + kstep, voffA); PG8_STAGE(PG8_SB(1, 1), cB + hstep + kstep, voffB);
        PG8_WAIT_V(6); PG8_BAR;
    } else {
        PG8_STAGE(PG8_SB(0, 0), cB, voffB); PG8_STAGE(PG8_SA(0, 0), cA, voffA); PG8_STAGE(PG8_SB(0, 1), cB + hstep, voffB); PG8_STAGE(PG8_SA(0, 1), cA + hstep, voffA);
        if (wr == 1) PG8_BAR;
        PG8_WAIT_V(4); PG8_BAR;
        PG8_STAGE(PG8_SB(1, 0), cB + kstep, voffB); PG8_STAGE(PG8_SA(1, 0), cA + kstep, voffA); PG8_STAGE(PG8_SB(1, 1), cB + hstep + kstep, voffB);
        PG8_WAIT_V(6); PG8_BAR;
    }
    for (;;) {
        const bool has_next = S.next(ui + 1, nxt); const int nt = cur.nkt;
        const char* nA = has_next ? (const char*)g.A + (size_t)nxt.pm * tstep + (size_t)nxt.ko * 2 : cA; const char* nB = has_next ? (const char*)g.Bt + (size_t)nxt.pn * tstep + (size_t)nxt.ko * 2 : cB;
        for (int t = 0; t < nt; t += 2) {
            const bool last = (t == nt - 2);
            const char* a1 = cA + (size_t)(t + 1) * kstep;
            const char* a2 = last ? nA : cA + (size_t)(t + 2) * kstep; const char* b2 = last ? nB : cB + (size_t)(t + 2) * kstep;
            const char* a3 = a2 + kstep; const char* b3 = b2 + kstep;
            if (last && has_next) S.a_ready(nxt);
            if constexpr (SP2) {
            PG8_LDB(B0, 0, 0); PG8_LDB(B1, 0, 1); PG8_SCHED; PG8_LDA(At, 0, 0); PG8_STAGE(PG8_SA(1, 1), a1 + hstep, voffA);
            PG8_WAIT_V(8); PG8_WAIT_L(0); PG8_BAR; PG8_MMA(0, 0, At, B0); PG8_MMA(0, 1, At, B1); PG8_BAR; PG8_SCHED;
            PG8_LDA(At, 0, 1); PG8_STAGE(PG8_SB(0, 0), b2, voffB); PG8_STAGE(PG8_SB(0, 1), b2 + hstep, voffB); PG8_STAGE(PG8_SA(0, 0), a2, voffA);
            PG8_WAIT_V(8); PG8_WAIT_L(0); PG8_BAR; PG8_MMA(1, 0, At, B0); PG8_MMA(1, 1, At, B1); PG8_BAR; PG8_SCHED;
            PG8_LDB(B0, 1, 0); PG8_LDB(B1, 1, 1); PG8_SCHED; PG8_LDA(At, 1, 0); PG8_STAGE(PG8_SA(0, 1), a2 + hstep, voffA);
            PG8_WAIT_V(8); PG8_WAIT_L(0); PG8_BAR; PG8_MMA(0, 0, At, B0); PG8_MMA(0, 1, At, B1); PG8_BAR; PG8_SCHED;
            PG8_LDA(At, 1, 1); PG8_STAGE(PG8_SB(1, 0), b3, voffB); PG8_STAGE(PG8_SB(1, 1), b3 + hstep, voffB); PG8_STAGE(PG8_SA(1, 0), a3, voffA);
            PG8_WAIT_V(8); PG8_WAIT_L(0); PG8_BAR; PG8_MMA(1, 0, At, B0); PG8_MMA(1, 1, At, B1); PG8_BAR; PG8_SCHED;
            } else {
            PG8_LDB(B0, 0, 0); PG8_SCHED; PG8_LDA(At, 0, 0); PG8_STAGE(PG8_SA(1, 1), a1 + hstep, voffA);
            PG8_WAIT_L(8); PG8_BAR; PG8_WAIT_L(0); PG8_MMA(0, 0, At, B0); PG8_BAR; PG8_SCHED;
            PG8_LDB(B1, 0, 1); PG8_STAGE(PG8_SB(0, 0), b2, voffB);
            PG8_BAR; PG8_WAIT_L(0); PG8_MMA(0, 1, At, B1); PG8_BAR;
            PG8_LDA(At, 0, 1); PG8_STAGE(PG8_SA(0, 0), a2, voffA);
            PG8_BAR; PG8_WAIT_L(0); PG8_MMA(1, 0, At, B0); PG8_BAR; PG8_SCHED;
            PG8_STAGE(PG8_SB(0, 1), b2 + hstep, voffB);
            PG8_WAIT_V(6); PG8_BAR; PG8_MMA(1, 1, At, B1); PG8_BAR;
            PG8_LDB(B0, 1, 0); PG8_SCHED; PG8_LDA(At, 1, 0); PG8_STAGE(PG8_SA(0, 1), a2 + hstep, voffA);
            PG8_WAIT_L(8); PG8_BAR; PG8_WAIT_L(0); PG8_MMA(0, 0, At, B0); PG8_BAR; PG8_SCHED;
            PG8_LDB(B1, 1, 1); PG8_STAGE(PG8_SB(1, 0), b3, voffB);
            PG8_BAR; PG8_WAIT_L(0); PG8_MMA(0, 1, At, B1); PG8_BAR;
            PG8_LDA(At, 1, 1); PG8_STAGE(PG8_SA(1, 0), a3, voffA);
            PG8_BAR; PG8_WAIT_L(0); PG8_MMA(1, 0, At, B0); PG8_BAR; PG8_SCHED;
            PG8_STAGE(PG8_SB(1, 1), b3 + hstep, voffB);
            PG8_WAIT_V(6); PG8_BAR; PG8_MMA(1, 1, At, B1); PG8_BAR;
            }
        }
        if constexpr (ALIGN_EPI) { if (wr == 0) PG8_BAR; }
        if constexpr (!Epi::AFTER_DRAIN) { E(acc, cur, wr, wc, fr, fq); S.done(cur); }
        if (!has_next) break;
#pragma unroll
        for (int a = 0; a < 2; ++a)
#pragma unroll
            for (int b = 0; b < 2; ++b)
#pragma unroll
                for (int m = 0; m < 4; ++m)
#pragma unroll
                    for (int n = 0; n < 2; ++n) acc[a][b][m][n] = (f32x4){0.f, 0.f, 0.f, 0.f};
        cur = nxt; cA = nA; cB = nB; ++ui;
        if constexpr (ALIGN_EPI) { if (wr == 1) PG8_BAR; }
    }
    PG8_WAIT_V(0);
    if constexpr (!ALIGN_EPI) { if (wr == 0) PG8_BAR; }
    PG8_BAR;
    if constexpr (Epi::AFTER_DRAIN) { E.fused(acc, cur, wr, wc, fr, fq, lds, wid, lane); S.done(cur); }
#undef PG8_SA
#undef PG8_SB
#undef PG8_STAGE
#undef PG8_LDA
#undef PG8_LDB
#undef PG8_MMA
#undef PG8_WAIT_V
#undef PG8_WAIT_L
#undef PG8_BAR
#undef PG8_SCHED
}
}
constexpr int NWAVES = 8;
#ifndef MK_PER_PHASE
#define MK_PER_PHASE 0
#endif
constexpr int N_PHASES = 20;

constexpr int NBATCH = 8, SEQ = 2048, LCTX = 256, DM = 1024, MLAT = NBATCH * SEQ, MCTX = NBATCH * LCTX, MALL = MLAT + MCTX;
constexpr int NPROJ = 3072, DIN = 2956, DFF = 4096;
constexpr int C_QA = 0, C_KA = 384, C_VA = 512, C_QR = 640, C_KR = 896, C_VR = 1152, C_GR = 1408, C_Z = 1664, C_XBC = 2048, C_DT = 2944;
constexpr int XBW = 896;
constexpr float EPS = 1e-6f;
constexpr float QSCALE = 0.125f * 1.4426950408889634f;
constexpr float LOG2E = 1.4426950408889634f;

constexpr size_t MiB = 1u << 20;
constexpr size_t WS_CTL = 0, CTL_ZERO_BYTES = 128 * 1024;
constexpr size_t WS_MOD = 1 * MiB;
constexpr size_t WS_WIN = 2 * MiB, WS_WOUT = 8 * MiB, WS_W1 = 10 * MiB, WS_W2 = 18 * MiB;
constexpr size_t WS_XN = 26 * MiB;
constexpr size_t WS_BIG = 62 * MiB;
constexpr size_t WS_XBC2 = 170 * MiB;
constexpr size_t WS_DTLA = 202 * MiB;
constexpr size_t WS_XC = 206 * MiB;
constexpr size_t WS_XB = 214 * MiB;
constexpr size_t WS_END = 256 * MiB;
static_assert(WS_BIG + (size_t)MALL * NPROJ * 2 <= WS_XBC2 && WS_XBC2 + (size_t)MALL * XBW * 2 <= WS_DTLA && WS_DTLA + (size_t)MALL * 24 * 4 <= WS_XC, "ws map 1");
static_assert(WS_BIG + (size_t)MALL * DFF * 2 <= WS_XC && WS_XB + (size_t)MLAT * DM * 2 <= WS_END && WS_XN + (size_t)MALL * DM * 2 <= WS_BIG, "ws map 2");
constexpr int CW_TMO = 0, CW_CODE = 1, CW_BAR = 4096, CW_QUEUE = 16384, CW_FLAGS = 20480;

constexpr int RING_OFF = 0, RING_BYTES = 131072;
constexpr int LDS_BYTES = 147456;
constexpr int LDSCTL_OFF = LDS_BYTES - 512, MISC_OFF = LDSCTL_OFF + 320;

#define GAS __attribute__((address_space(1)))
#define LAS __attribute__((address_space(3)))
typedef unsigned short bf16;
typedef unsigned v4u __attribute__((ext_vector_type(4)));
typedef unsigned v2u __attribute__((ext_vector_type(2)));
typedef float f32x4 __attribute__((ext_vector_type(4)));
typedef float f32x2 __attribute__((ext_vector_type(2)));
typedef float f32x16 __attribute__((ext_vector_type(16)));
typedef short bf16x8 __attribute__((ext_vector_type(8)));
typedef short s16x4 __attribute__((ext_vector_type(4)));
typedef __bf16 bf16x2_t __attribute__((ext_vector_type(2)));
typedef GAS unsigned gu32;
#define RLX_AGENT __ATOMIC_RELAXED, __HIP_MEMORY_SCOPE_AGENT
#define LDS_WAIT() asm volatile("s_waitcnt lgkmcnt(0)" ::: "memory")
#define VM_WAIT() asm volatile("s_waitcnt vmcnt(0)" ::: "memory")
__device__ __forceinline__ unsigned f2bf(float f) { unsigned u = __builtin_bit_cast(unsigned, f); return (u + 0x7fffu + ((u >> 16) & 1u)) >> 16; }
__device__ __forceinline__ unsigned pk2(float lo, float hi) { f32x2 v = {lo, hi}; bf16x2_t b = __builtin_convertvector(v, bf16x2_t); return __builtin_bit_cast(unsigned, b); }
__device__ __forceinline__ float bflo(unsigned u) { return __builtin_bit_cast(float, u << 16); }
__device__ __forceinline__ float bfhi(unsigned u) { return __builtin_bit_cast(float, u & 0xffff0000u); }
__device__ __forceinline__ float bf1(bf16 h) { return __builtin_bit_cast(float, (unsigned)h << 16); }
__device__ __forceinline__ float silu_f(float x) { return x / (1.f + expf(-x)); }
__device__ __forceinline__ float wave_sum(float v) {
#pragma unroll
    for (int o = 1; o < 64; o <<= 1) v += __shfl_xor(v, o);
    return v;
}
__device__ __forceinline__ float sum16(float v) {
    v += __shfl_xor(v, 1); v += __shfl_xor(v, 2); v += __shfl_xor(v, 4); v += __shfl_xor(v, 8); return v;
}
typedef short v4i16_t __attribute__((ext_vector_type(4)));
__device__ __forceinline__ s16x4 tr16(const LAS unsigned char* p) { return __builtin_bit_cast(s16x4, __builtin_amdgcn_ds_read_tr16_b64_v4i16((LAS v4i16_t*)p)); }
__device__ __forceinline__ float max3f(float a, float b, float c) { float r; asm("v_max3_f32 %0, %1, %2, %3" : "=v"(r) : "v"(a), "v"(b), "v"(c)); return r; }
#define CAT8(lo, hi) __builtin_shufflevector(lo, hi, 0, 1, 2, 3, 4, 5, 6, 7)
#define MFMA16(a, b, c) __builtin_amdgcn_mfma_f32_16x16x32_bf16((a), (b), (c), 0, 0, 0)
#define MFMA32(a, b, c) __builtin_amdgcn_mfma_f32_32x32x16_bf16((a), (b), (c), 0, 0, 0)

#define XB_TMO      128
#define XB_XCNT(j)  (256  + 64 * (j))
#define XB_XSUB(j)  (1280 + 64 * (j))
#define XB_XGEN(j)  (2304 + 64 * (j))
#define XB_TOP      3328
#define XB_TOPGEN   3392
#define XCD_BAR_WORDS 3456
#define XB_SPIN_CAP (1u << 18)

__device__ __forceinline__ unsigned xb_ld(unsigned* p)              { return __hip_atomic_load(p, __ATOMIC_RELAXED, __HIP_MEMORY_SCOPE_AGENT); }
__device__ __forceinline__ unsigned xb_add(unsigned* p, unsigned v) { return __hip_atomic_fetch_add(p, v, __ATOMIC_RELAXED, __HIP_MEMORY_SCOPE_AGENT); }
__device__ __forceinline__ unsigned xb_xcc_id() { return (unsigned)__builtin_amdgcn_s_getreg((3 << 11) | 20) & 0xFu; }
#define XB_SPIN(cond, bar) do { unsigned _sp = 0; while (cond) { __builtin_amdgcn_s_sleep(1); \
    if ((++_sp & 255u) == 0u) { if (xb_ld(&(bar)[XB_TMO])) break; if (_sp > XB_SPIN_CAP) { atomicAdd(&(bar)[XB_TMO], 1u); break; } } } } while (0)

struct XcdBarrier {
    unsigned* bar; unsigned x;
    volatile LAS unsigned* st;
};

__device__ __forceinline__ XcdBarrier xcd_barrier_post(unsigned* bar, volatile LAS unsigned* st) {
    XcdBarrier b; b.bar = bar; b.x = xb_xcc_id(); b.st = st;
    if (threadIdx.x == 0) (void)xb_add(&bar[XB_XCNT(b.x)], 1u);
    return b;
}
__device__ __forceinline__ void xcd_barrier_complete(unsigned* bar, unsigned x, unsigned& nloc, unsigned& nx) {
    const unsigned G = gridDim.x * gridDim.y * gridDim.z;
    unsigned sum, cnt, mine, sp = 0u;
    for (;;) {
        sum = 0u; cnt = 0u; mine = 0u;
#pragma unroll
        for (unsigned j = 0; j < 16; ++j) { const unsigned c = xb_ld(&bar[XB_XCNT(j)]); sum += c; cnt += (c > 0u) ? 1u : 0u; mine = (j == x) ? c : mine; }
        if (sum == G) break;
        __builtin_amdgcn_s_sleep(1);
        if ((++sp & 255u) == 0u) { if (xb_ld(&bar[XB_TMO])) break; if (sp > XB_SPIN_CAP) { atomicAdd(&bar[XB_TMO], 1u); break; } }
    }
    nloc = mine > 0u ? mine : 1u; nx = cnt > 0u ? cnt : 1u;
}

__device__ __forceinline__ void xcd_barrier(const XcdBarrier& b) {
    asm volatile("s_waitcnt vmcnt(0)" ::: "memory");
    __syncthreads();
    if (threadIdx.x == 0) {
        unsigned* bar = b.bar;
        __builtin_amdgcn_s_waitcnt(0);
        unsigned nloc = b.st[0], nx = b.st[1];
        if (nloc == 0u) { xcd_barrier_complete(bar, b.x, nloc, nx); b.st[0] = nloc; b.st[1] = nx; }
        const unsigned old = xb_add(&bar[XB_XSUB(b.x)], 1u);
        const unsigned gen = old / nloc;
        if (old + 1u == (gen + 1u) * nloc) {
            __builtin_amdgcn_fence(__ATOMIC_RELEASE, "agent");
            asm volatile("s_waitcnt vmcnt(0)" ::: "memory");
            const unsigned og = xb_add(&bar[XB_TOP], 1u);
            const unsigned tg = og / nx;
            if (og + 1u == (tg + 1u) * nx) xb_add(&bar[XB_TOPGEN], 1u);
            else XB_SPIN(xb_ld(&bar[XB_TOPGEN]) == tg, bar);
            __builtin_amdgcn_fence(__ATOMIC_ACQUIRE, "agent");
            xb_add(&bar[XB_XGEN(b.x)], 1u);
            asm volatile("s_waitcnt vmcnt(0)" ::: "memory");
        } else {
            XB_SPIN(xb_ld(&bar[XB_XGEN(b.x)]) == gen, bar);
            __builtin_amdgcn_fence(__ATOMIC_ACQUIRE, "agent");
            asm volatile("s_waitcnt vmcnt(0)" ::: "memory");
        }
    }
    __syncthreads();
}
struct Frame {
    LAS unsigned char* lds;
    volatile LAS unsigned* MISC;
    gu32* ctl;
    int tid, lane, wave;
    int vcu, G;
};
struct Args { const float* in[22]; float* out; unsigned char* ws; int ph_lo, ph_hi, li, pad; };

__host__ __device__ __forceinline__ int proj_natural(int pos) {
    if (pos >= 1152) return pos;
    if (pos >= 1024) return pos - 512;
    const int tile = pos >> 8, bj = (pos >> 7) & 1, wc = (pos >> 5) & 3, dim = 32 * bj + (pos & 31);
    const int base = tile == 0 ? wc * 64 : tile == 1 ? (wc < 2 ? (4 + wc) * 64 : C_KA + (wc - 2) * 64) : tile == 2 ? C_QR + wc * 64 : C_KR + wc * 64;
    return base + dim;
}
__device__ __forceinline__ void transpose_item(const float* W, int K, int Nreal, int nblk, bf16* WT, LAS float* scr, int item, int lane, bool permw = false) {
    const int kb = item / nblk, nb = item % nblk, k0 = 64 * kb, n0 = 32 * nb;
    const int nn = (permw ? proj_natural(n0) : n0) + (lane & 31); const bool okn = nn < Nreal; const int nnc = okn ? nn : Nreal - 1;
    float wv[32];
#pragma unroll
    for (int i = 0; i < 32; ++i) { const int kk = 2 * i + (lane >> 5); wv[i] = __builtin_nontemporal_load((const GAS float*)W + (size_t)(k0 + kk) * Nreal + nnc); }
#pragma unroll
    for (int i = 0; i < 32; ++i) { const int kk = 2 * i + (lane >> 5); scr[kk * 33 + (lane & 31)] = okn ? wv[i] : 0.f; }
    LDS_WAIT(); asm volatile("" ::: "memory");
    const int c = lane & 7;
#pragma unroll
    for (int j = 0; j < 4; ++j) { const int n = (lane >> 3) + 8 * j; const LAS float* s = scr + (8 * c) * 33 + n;
        v4u o; o.x = pk2(s[0 * 33], s[1 * 33]); o.y = pk2(s[2 * 33], s[3 * 33]); o.z = pk2(s[4 * 33], s[5 * 33]); o.w = pk2(s[6 * 33], s[7 * 33]);
        *(GAS v4u*)(WT + (size_t)(n0 + n) * K + k0 + 8 * c) = o; }
    LDS_WAIT(); asm volatile("" ::: "memory");
}
__device__ __forceinline__ void convert_weights(Frame& F, const Args& A, int layer, int part) {
    LAS float* scr = (LAS float*)(F.lds + RING_OFF + F.wave * 16384);
    const int gw = F.vcu * NWAVES + F.wave, NGW = F.G * NWAVES;
    const float* Win = A.in[7] + (size_t)layer * DM * DIN; const float* Wout = A.in[8] + (size_t)layer * DM * DM;
    const float* W1 = A.in[20] + (size_t)layer * DM * DFF; const float* W2 = A.in[21] + (size_t)layer * DFF * DM;
    bf16* Win_t = (bf16*)(A.ws + WS_WIN); bf16* Wout_t = (bf16*)(A.ws + WS_WOUT); bf16* W1_t = (bf16*)(A.ws + WS_W1); bf16* W2_t = (bf16*)(A.ws + WS_W2);
    constexpr int I_IN = (DM / 64) * (NPROJ / 32), I_OUT = (DM / 64) * (DM / 32), I_1 = (DM / 64) * (DFF / 32), I_2 = (DFF / 64) * (DM / 32);
    if (part == 0) { for (int it = gw; it < I_IN; it += NGW) transpose_item(Win, DM, DIN, NPROJ / 32, Win_t, scr, it, F.lane, true); return; }
    if (part == 2) {
        const int h0 = (MALL / 256) * (DFF / 256) - 4 * F.G; const int w0 = (h0 > 0 && h0 < F.G) ? h0 : 0; if ((int)blockIdx.x < w0) return;
        for (int it = ((int)blockIdx.x - w0) * NWAVES + F.wave; it < I_IN; it += (F.G - w0) * NWAVES) transpose_item(Win, DM, DIN, NPROJ / 32, Win_t, scr, it, F.lane, true);
        return; }
    const int idle0 = (MALL / 256) * (NPROJ / 256) - 3 * F.G;
    const int w0 = (idle0 > 0 && idle0 < F.G) ? idle0 : 0; if ((int)blockIdx.x < w0) return;
    for (int it = ((int)blockIdx.x - w0) * NWAVES + F.wave; it < I_OUT + I_1 + I_2; it += (F.G - w0) * NWAVES) {
        int r = it;
        if (r < I_OUT) { transpose_item(Wout, DM, DM, DM / 32, Wout_t, scr, r, F.lane); continue; } r -= I_OUT;
        if (r < I_1) { transpose_item(W1, DM, DFF, DFF / 32, W1_t, scr, r, F.lane); continue; } r -= I_1;
        transpose_item(W2, DFF, DM, DM / 32, W2_t, scr, r, F.lane);
    }
}
__device__ __forceinline__ void mod_phase(Frame& F, const Args& A) {
    LAS float* sact = (LAS float*)(F.lds + RING_OFF);
    LAS float* red = (LAS float*)(F.lds + RING_OFF + 36864);
    float* MOD = (float*)(A.ws + WS_MOD);
    bool have = false;
    for (int unit = F.vcu; unit < 2 * 96; unit += F.G) {
        if (!have) {
            for (int i = F.tid; i < 9 * 1024; i += NWAVES * 64) { const int r = i >> 10, k = i & 1023; const float v = r < 8 ? A.in[1][r * DM + k] : A.in[3][k]; sact[i] = silu_f(v); }
            __syncthreads(); have = true;
        }
        const int layer = unit / 96, cb = unit % 96;
        const float* W = A.in[4] + (size_t)layer * DM * 6144 + cb * 64 + F.lane;
        float acc[9];
#pragma unroll
        for (int r = 0; r < 9; ++r) acc[r] = 0.f;
        for (int kk0 = 0; kk0 < 128; kk0 += 32) { float wv[32];
#pragma unroll
            for (int j = 0; j < 32; ++j) wv[j] = __builtin_nontemporal_load((const GAS float*)W + (size_t)(F.wave * 128 + kk0 + j) * 6144);
#pragma unroll
            for (int j = 0; j < 32; ++j) { const int k = F.wave * 128 + kk0 + j;
#pragma unroll
                for (int r = 0; r < 9; ++r) acc[r] += sact[r * 1024 + k] * wv[j]; } }
#pragma unroll
        for (int r = 0; r < 9; ++r) red[(F.wave * 9 + r) * 64 + F.lane] = acc[r];
        __syncthreads();
        for (int i = F.tid; i < 576; i += NWAVES * 64) { const int r = i >> 6, l = i & 63; float s = 0.f;
#pragma unroll
            for (int w = 0; w < 8; ++w) s += red[(w * 9 + r) * 64 + l];
            MOD[(size_t)(layer * 9 + r) * 6144 + cb * 64 + l] = s + A.in[5][layer * 6144 + cb * 64 + l]; }
        __syncthreads();
    }
    __syncthreads();
}

struct RowPass {
    const void* xs_lat; const float* xs_ctx; const bf16* o; void* xd_lat; float* xd_ctx; bf16* xn;
    const float* gate; const float* ngo; const float* ngx; const float* scale; const float* shift; int M; const bf16* oslab;
};
__device__ __forceinline__ f32x4 bf4(v2u w) { return (f32x4){bflo(w.x), bfhi(w.x), bflo(w.y), bfhi(w.y)}; }
template <int NR, int XS, int XD>
__device__ __forceinline__ void row_pass_rows(const RowPass& P, const int (&mr)[NR], int lane) {
    f32x4 v[NR][4], ov[NR][4]; int mrow[NR]; bool lat[NR];
#pragma unroll
    for (int q = 0; q < NR; ++q) { const int m = mr[q]; lat[q] = m < MLAT; mrow[q] = lat[q] ? (m >> 11) : 8;
        if (XS == 1 && lat[q]) { const v2u* xr = (const v2u*)((const bf16*)P.xs_lat + (size_t)m * DM);
#pragma unroll
            for (int j = 0; j < 4; ++j) v[q][j] = bf4(__builtin_nontemporal_load(xr + lane + 64 * j));
        } else { const float* xr = lat[q] ? (const float*)P.xs_lat + (size_t)m * DM : P.xs_ctx + (size_t)(m - MLAT) * DM;
#pragma unroll
            for (int j = 0; j < 4; ++j) v[q][j] = __builtin_nontemporal_load((const f32x4*)xr + lane + 64 * j); } }
    if (P.o) {
#pragma unroll
        for (int q = 0; q < NR; ++q) { const int m = mr[q];
            if (!lat[q] && P.oslab) {
#pragma unroll
                for (int j = 0; j < 4; ++j) ov[q][j] = (f32x4){0.f, 0.f, 0.f, 0.f};
                v2u sw[8][4];
#pragma unroll
                for (int ks = 0; ks < 8; ++ks) { const v2u* orow = (const v2u*)(P.oslab + ((size_t)ks * MCTX + (m - MLAT)) * DM);
#pragma unroll
                    for (int j = 0; j < 4; ++j) sw[ks][j] = __builtin_nontemporal_load(orow + lane + 64 * j); }
#pragma unroll
                for (int ks = 0; ks < 8; ++ks)
#pragma unroll
                    for (int j = 0; j < 4; ++j) ov[q][j] = ov[q][j] + bf4(sw[ks][j]);
            } else { const v2u* orow = (const v2u*)(P.o + (size_t)m * DM);
#pragma unroll
                for (int j = 0; j < 4; ++j) { const v2u w = __builtin_nontemporal_load(orow + lane + 64 * j); ov[q][j] = bf4(w); } } }
        float ss[NR];
#pragma unroll
        for (int q = 0; q < NR; ++q) { ss[q] = 0.f;
#pragma unroll
            for (int j = 0; j < 4; ++j) ss[q] += (ov[q][j].x * ov[q][j].x + ov[q][j].y * ov[q][j].y) + (ov[q][j].z * ov[q][j].z + ov[q][j].w * ov[q][j].w); }
#pragma unroll
        for (int o = 1; o < 64; o <<= 1) {
#pragma unroll
            for (int q = 0; q < NR; ++q) ss[q] += __shfl_xor(ss[q], o); }
#pragma unroll
        for (int q = 0; q < NR; ++q) { const float rstd = rsqrtf(ss[q] * (1.f / DM) + EPS);
#pragma unroll
            for (int j = 0; j < 4; ++j) { const f32x4 g4 = ((const f32x4*)(P.gate + (size_t)mrow[q] * 6144))[lane + 64 * j]; const f32x4 n4 = ((const f32x4*)P.ngo)[lane + 64 * j];
                v[q][j] = v[q][j] + g4 * ((ov[q][j] * rstd) * n4); } }
    }
#pragma unroll
    for (int q = 0; q < NR; ++q) { const int m = mr[q];
        if (lat[q]) {
            if (P.xd_lat) {
                if (XD == 1) { v2u* xd = (v2u*)((bf16*)P.xd_lat + (size_t)m * DM);
#pragma unroll
                    for (int j = 0; j < 4; ++j) { v2u w; w.x = pk2(v[q][j].x, v[q][j].y); w.y = pk2(v[q][j].z, v[q][j].w); __builtin_nontemporal_store(w, xd + lane + 64 * j); }
                } else { float* xd = (float*)P.xd_lat + (size_t)m * DM;
#pragma unroll
                    for (int j = 0; j < 4; ++j) __builtin_nontemporal_store(v[q][j], (f32x4*)xd + lane + 64 * j); } }
        } else if (P.xd_ctx) { float* xd = P.xd_ctx + (size_t)(m - MLAT) * DM;
#pragma unroll
            for (int j = 0; j < 4; ++j) __builtin_nontemporal_store(v[q][j], (f32x4*)xd + lane + 64 * j); } }
    if (P.xn) {
        float ss[NR];
#pragma unroll
        for (int q = 0; q < NR; ++q) { ss[q] = 0.f;
#pragma unroll
            for (int j = 0; j < 4; ++j) ss[q] += (v[q][j].x * v[q][j].x + v[q][j].y * v[q][j].y) + (v[q][j].z * v[q][j].z + v[q][j].w * v[q][j].w); }
#pragma unroll
        for (int o = 1; o < 64; o <<= 1) {
#pragma unroll
            for (int q = 0; q < NR; ++q) ss[q] += __shfl_xor(ss[q], o); }
#pragma unroll
        for (int q = 0; q < NR; ++q) { const float rstd = rsqrtf(ss[q] * (1.f / DM) + EPS); v2u* xo = (v2u*)(P.xn + (size_t)mr[q] * DM);
#pragma unroll
            for (int j = 0; j < 4; ++j) { const f32x4 n4 = ((const f32x4*)P.ngx)[lane + 64 * j]; const f32x4 sc = ((const f32x4*)(P.scale + (size_t)mrow[q] * 6144))[lane + 64 * j];
                const f32x4 sh = ((const f32x4*)(P.shift + (size_t)mrow[q] * 6144))[lane + 64 * j];
                const f32x4 y = ((v[q][j] * rstd) * n4) * (sc + 1.f) + sh; v2u w; w.x = pk2(y.x, y.y); w.y = pk2(y.z, y.w); xo[lane + 64 * j] = w; } }
    }
}
template <int XS> struct RowRaw;
template <> struct RowRaw<0> { f32x4 x[2][4]; v2u o[2][4]; };
template <> struct RowRaw<1> { v2u x[2][4]; v2u o[2][4]; };
template <int XS>
__device__ __forceinline__ void row_raw_load(const RowPass& P, RowRaw<XS>& R, int m0, int m1, int lane) {
    const int mr[2] = {m0, m1};
#pragma unroll
    for (int q = 0; q < 2; ++q) {
        if constexpr (XS == 1) { const v2u* xr = (const v2u*)((const bf16*)P.xs_lat + (size_t)mr[q] * DM);
#pragma unroll
            for (int j = 0; j < 4; ++j) R.x[q][j] = __builtin_nontemporal_load(xr + lane + 64 * j);
        } else { const float* xr = (const float*)P.xs_lat + (size_t)mr[q] * DM;
#pragma unroll
            for (int j = 0; j < 4; ++j) R.x[q][j] = __builtin_nontemporal_load((const f32x4*)xr + lane + 64 * j); }
        if (P.o) { const v2u* orow = (const v2u*)(P.o + (size_t)mr[q] * DM);
#pragma unroll
            for (int j = 0; j < 4; ++j) R.o[q][j] = __builtin_nontemporal_load(orow + lane + 64 * j); } }
}
template <int XS, int XD>
__device__ __forceinline__ void row_raw_compute(const RowPass& P, const RowRaw<XS>& R, int m0, int m1, int lane) {
    const int mr[2] = {m0, m1}; f32x4 v[2][4];
#pragma unroll
    for (int q = 0; q < 2; ++q)
#pragma unroll
        for (int j = 0; j < 4; ++j) { if constexpr (XS == 1) v[q][j] = bf4(R.x[q][j]); else v[q][j] = R.x[q][j]; }
    if (P.o) {
        f32x4 ov[2][4]; float ss[2];
#pragma unroll
        for (int q = 0; q < 2; ++q) { ss[q] = 0.f;
#pragma unroll
            for (int j = 0; j < 4; ++j) { ov[q][j] = bf4(R.o[q][j]);
                ss[q] += (ov[q][j].x * ov[q][j].x + ov[q][j].y * ov[q][j].y) + (ov[q][j].z * ov[q][j].z + ov[q][j].w * ov[q][j].w); } }
#pragma unroll
        for (int o = 1; o < 64; o <<= 1) { ss[0] += __shfl_xor(ss[0], o); ss[1] += __shfl_xor(ss[1], o); }
#pragma unroll
        for (int q = 0; q < 2; ++q) { const float rstd = rsqrtf(ss[q] * (1.f / DM) + EPS); const int mrow = mr[q] >> 11;
#pragma unroll
            for (int j = 0; j < 4; ++j) { const f32x4 g4 = ((const f32x4*)(P.gate + (size_t)mrow * 6144))[lane + 64 * j]; const f32x4 n4 = ((const f32x4*)P.ngo)[lane + 64 * j];
                v[q][j] = v[q][j] + g4 * ((ov[q][j] * rstd) * n4); } }
    }
    if (P.xd_lat) {
#pragma unroll
        for (int q = 0; q < 2; ++q)
#pragma unroll
            for (int j = 0; j < 4; ++j) {
                if constexpr (XD == 1) { v2u w; w.x = pk2(v[q][j].x, v[q][j].y); w.y = pk2(v[q][j].z, v[q][j].w); __builtin_nontemporal_store(w, (v2u*)((bf16*)P.xd_lat + (size_t)mr[q] * DM) + lane + 64 * j); }
                else __builtin_nontemporal_store(v[q][j], (f32x4*)((float*)P.xd_lat + (size_t)mr[q] * DM) + lane + 64 * j); } }
    if (P.xn) {
        float ss[2];
#pragma unroll
        for (int q = 0; q < 2; ++q) { ss[q] = 0.f;
#pragma unroll
            for (int j = 0; j < 4; ++j) ss[q] += (v[q][j].x * v[q][j].x + v[q][j].y * v[q][j].y) + (v[q][j].z * v[q][j].z + v[q][j].w * v[q][j].w); }
#pragma unroll
        for (int o = 1; o < 64; o <<= 1) { ss[0] += __shfl_xor(ss[0], o); ss[1] += __shfl_xor(ss[1], o); }
#pragma unroll
        for (int q = 0; q < 2; ++q) { const float rstd = rsqrtf(ss[q] * (1.f / DM) + EPS); const int mrow = mr[q] >> 11; v2u* xo = (v2u*)(P.xn + (size_t)mr[q] * DM);
#pragma unroll
            for (int j = 0; j < 4; ++j) { const f32x4 n4 = ((const f32x4*)P.ngx)[lane + 64 * j]; const f32x4 sc = ((const f32x4*)(P.scale + (size_t)mrow * 6144))[lane + 64 * j];
                const f32x4 sh = ((const f32x4*)(P.shift + (size_t)mrow * 6144))[lane + 64 * j];
                const f32x4 y = ((v[q][j] * rstd) * n4) * (sc + 1.f) + sh; v2u w; w.x = pk2(y.x, y.y); w.y = pk2(y.z, y.w); xo[lane + 64 * j] = w; } }
    }
}
template <int XS, int XD>
__device__ __forceinline__ void row_raw_compute1(const RowPass& P, const RowRaw<XS>& R, const int q, int m, int lane) {
    f32x4 v[4];
#pragma unroll
    for (int j = 0; j < 4; ++j) { if constexpr (XS == 1) v[j] = bf4(R.x[q][j]); else v[j] = R.x[q][j]; }
    const int mrow = m >> 11;
    if (P.o) {
        f32x4 ov[4]; float ss = 0.f;
#pragma unroll
        for (int j = 0; j < 4; ++j) { ov[j] = bf4(R.o[q][j]); ss += (ov[j].x * ov[j].x + ov[j].y * ov[j].y) + (ov[j].z * ov[j].z + ov[j].w * ov[j].w); }
#pragma unroll
        for (int o = 1; o < 64; o <<= 1) ss += __shfl_xor(ss, o);
        const float rstd = rsqrtf(ss * (1.f / DM) + EPS);
#pragma unroll
        for (int j = 0; j < 4; ++j) { const f32x4 g4 = ((const f32x4*)(P.gate + (size_t)mrow * 6144))[lane + 64 * j]; const f32x4 n4 = ((const f32x4*)P.ngo)[lane + 64 * j];
            v[j] = v[j] + g4 * ((ov[j] * rstd) * n4); }
    }
    if (P.xd_lat) {
#pragma unroll
        for (int j = 0; j < 4; ++j) {
            if constexpr (XD == 1) { v2u w; w.x = pk2(v[j].x, v[j].y); w.y = pk2(v[j].z, v[j].w); __builtin_nontemporal_store(w, (v2u*)((bf16*)P.xd_lat + (size_t)m * DM) + lane + 64 * j); }
            else __builtin_nontemporal_store(v[j], (f32x4*)((float*)P.xd_lat + (size_t)m * DM) + lane + 64 * j); } }
    if (P.xn) {
        float ss = 0.f;
#pragma unroll
        for (int j = 0; j < 4; ++j) ss += (v[j].x * v[j].x + v[j].y * v[j].y) + (v[j].z * v[j].z + v[j].w * v[j].w);
#pragma unroll
        for (int o = 1; o < 64; o <<= 1) ss += __shfl_xor(ss, o);
        const float rstd = rsqrtf(ss * (1.f / DM) + EPS); v2u* xo = (v2u*)(P.xn + (size_t)m * DM);
#pragma unroll
        for (int j = 0; j < 4; ++j) { const f32x4 n4 = ((const f32x4*)P.ngx)[lane + 64 * j]; const f32x4 sc = ((const f32x4*)(P.scale + (size_t)mrow * 6144))[lane + 64 * j];
            const f32x4 sh = ((const f32x4*)(P.shift + (size_t)mrow * 6144))[lane + 64 * j];
            const f32x4 y = ((v[j] * rstd) * n4) * (sc + 1.f) + sh; v2u w; w.x = pk2(y.x, y.y); w.y = pk2(y.z, y.w); xo[lane + 64 * j] = w; }
    }
}
template <int XS, int XD, bool QUAD = (XS == 1)>
__device__ __forceinline__ void row_pass(Frame& F, const RowPass& P) {
    const int gw = F.vcu * NWAVES + F.wave, NGW = F.G * NWAVES, lane = F.lane;
    const int Ml = P.M < MLAT ? P.M : MLAT;
    int m = gw;
    if constexpr (QUAD) {
        if (m + 3 * NGW < Ml) {
            RowRaw<XS> c0, c1; row_raw_load<XS>(P, c0, m, m + NGW, lane); row_raw_load<XS>(P, c1, m + 2 * NGW, m + 3 * NGW, lane);
            for (;;) {
                const int mn = m + 4 * NGW; const bool more = mn + 3 * NGW < Ml;
                RowRaw<XS> n0, n1;
                if (more) { row_raw_load<XS>(P, n0, mn, mn + NGW, lane); row_raw_load<XS>(P, n1, mn + 2 * NGW, mn + 3 * NGW, lane); }
                row_raw_compute1<XS, XD>(P, c0, 0, m, lane); row_raw_compute1<XS, XD>(P, c0, 1, m + NGW, lane);
                row_raw_compute1<XS, XD>(P, c1, 0, m + 2 * NGW, lane); row_raw_compute1<XS, XD>(P, c1, 1, m + 3 * NGW, lane);
                m = mn;
                if (!more) break;
                c0 = n0; c1 = n1;
            }
        }
    }
    if (m + NGW < Ml) {
        RowRaw<XS> cur; row_raw_load<XS>(P, cur, m, m + NGW, lane);
        for (;;) {
            const int mn = m + 2 * NGW; const bool more = mn + NGW < Ml;
            RowRaw<XS> nxt;
            if (more) row_raw_load<XS>(P, nxt, mn, mn + NGW, lane);
            row_raw_compute<XS, XD>(P, cur, m, m + NGW, lane);
            m = mn;
            if (!more) break;
            cur = nxt;
        }
    }
    for (; m < P.M; m += NGW) { const int mr[1] = {m}; row_pass_rows<1, XS, XD>(P, mr, lane); }
}

constexpr int ROPE_LDS_OFF = 131072;
__device__ __forceinline__ void fill_rope_table(Frame& F) {
    LAS float* tab = (LAS float*)(F.lds + ROPE_LDS_OFF);
    for (int i = F.tid; i < 1024; i += NWAVES * 64) { const int pos = i >> 4, j = i & 15; const float rev = (float)pos * exp2f(-(float)j * 0.83048202372184058696f) * 0.15915494309189533577f; const float fr = rev - floorf(rev);
        tab[2 * i] = __builtin_amdgcn_cosf(fr); tab[2 * i + 1] = __builtin_amdgcn_sinf(fr); }
    __syncthreads();
}
struct EpiProj {
    static constexpr bool PERM = true, AFTER_DRAIN = false;
    bf16* O; const float* qn; const float* kn; const LAS float* rope;
    __device__ __forceinline__ void operator()(const pg8::f32x4 (&acc)[2][2][4][2], const pg8::Unit& u, int wr, int wc, int fr, int fq) const {
        const int row0 = u.pm * 256 + wr * 64 + fr;
        if (u.pn >= 4) {
#pragma unroll
            for (int ai = 0; ai < 2; ++ai)
#pragma unroll
                for (int m = 0; m < 4; ++m) { bf16* rowp = O + (size_t)(row0 + ai * 128 + m * 16) * NPROJ;
#pragma unroll
                    for (int bj = 0; bj < 2; ++bj) { const int pos = u.pn * 256 + bj * 128 + wc * 32 + 8 * fq; const int col = pos < 1152 ? pos - 512 : pos;
                        const pg8::f32x4 v0 = acc[ai][bj][m][0], v1 = acc[ai][bj][m][1];
                        v4u w; w.x = pk2(v0[0], v0[1]); w.y = pk2(v0[2], v0[3]); w.z = pk2(v1[0], v1[1]); w.w = pk2(v1[2], v1[3]);
                        *(v4u*)(rowp + col) = w; } }
            return;
        }
        const int pn = u.pn; const bool att = pn < 2, iskatt = (pn == 1) && (wc >= 2), lat = u.pm < MLAT / 256;
        const int hb = pn == 0 ? wc * 64 : pn == 1 ? (wc < 2 ? (4 + wc) * 64 : C_KA + (wc - 2) * 64) : pn == 2 ? C_QR + wc * 64 : C_KR + wc * 64;
        const float scl = att ? (iskatt ? 1.f : QSCALE) : (pn == 3 ? 0.125f : 1.f);
        float gn[2][8];
        { const float* gp = iskatt ? kn : qn;
#pragma unroll
          for (int bj = 0; bj < 2; ++bj) { const f32x4 a = *(const f32x4*)(gp + 32 * bj + 8 * fq), b = *(const f32x4*)(gp + 32 * bj + 8 * fq + 4);
              gn[bj][0] = a.x; gn[bj][1] = a.y; gn[bj][2] = a.z; gn[bj][3] = a.w; gn[bj][4] = b.x; gn[bj][5] = b.y; gn[bj][6] = b.z; gn[bj][7] = b.w; } }
        const bool up = (fq >> 1) & 1; const int jb = 8 * (fq & 1);
#pragma unroll
        for (int ai = 0; ai < 2; ++ai)
#pragma unroll
            for (int m = 0; m < 4; ++m) {
                const int r = row0 + ai * 128 + m * 16; float x[2][8];
#pragma unroll
                for (int bj = 0; bj < 2; ++bj)
#pragma unroll
                    for (int e = 0; e < 8; ++e) x[bj][e] = acc[ai][bj][m][e >> 2][e & 3];
                if (att) { float ss = 0.f;
#pragma unroll
                    for (int bj = 0; bj < 2; ++bj)
#pragma unroll
                        for (int e = 0; e < 8; ++e) ss += x[bj][e] * x[bj][e];
                    ss += __shfl_xor(ss, 16); ss += __shfl_xor(ss, 32);
                    const float rstd = rsqrtf(ss * (1.f / 64.f) + EPS);
#pragma unroll
                    for (int bj = 0; bj < 2; ++bj)
#pragma unroll
                        for (int e = 0; e < 8; ++e) x[bj][e] = (x[bj][e] * rstd) * gn[bj][e]; }
                if (lat) { const int t = r & (SEQ - 1);
#pragma unroll
                    for (int bj = 0; bj < 2; ++bj) { const int pos = bj ? (t & 63) : (t >> 6); const LAS f32x4* tp = (const LAS f32x4*)(rope + (pos * 16 + jb) * 2);
                        const f32x4 t0 = tp[0], t1 = tp[1], t2 = tp[2], t3 = tp[3];
                        const float cs[8] = {t0.x, t0.z, t1.x, t1.z, t2.x, t2.z, t3.x, t3.z}, sn[8] = {t0.y, t0.w, t1.y, t1.w, t2.y, t2.w, t3.y, t3.w};
#pragma unroll
                        for (int e = 0; e < 8; ++e) { const float pr = __shfl_xor(x[bj][e], 32); x[bj][e] = up ? (x[bj][e] * cs[e] + pr * sn[e]) : (x[bj][e] * cs[e] - pr * sn[e]); } } }
                bf16* rowp = O + (size_t)r * NPROJ + hb + 8 * fq;
#pragma unroll
                for (int bj = 0; bj < 2; ++bj) { v4u w; w.x = pk2(x[bj][0] * scl, x[bj][1] * scl); w.y = pk2(x[bj][2] * scl, x[bj][3] * scl); w.z = pk2(x[bj][4] * scl, x[bj][5] * scl); w.w = pk2(x[bj][6] * scl, x[bj][7] * scl);
                    *(v4u*)(rowp + 32 * bj) = w; }
            }
    }
};
__device__ __forceinline__ void prep_rows(const Args& A, unsigned char* ws, int layer, int rowbase, int nrows, int gt, int NGT) {
    bf16* PROJ = (bf16*)(ws + WS_BIG); bf16* XBC2 = (bf16*)(ws + WS_XBC2); float* DTLA = (float*)(ws + WS_DTLA);
    {
        const float* cw = A.in[14] + (size_t)layer * 5 * XBW; const float* cb = A.in[15] + (size_t)layer * XBW;
        constexpr int NCH = XBW / 8; const int NIT = (nrows / 16) * NCH;
        for (int it = gt; it < NIT; it += NGT) {
            const int run = it / NCH, ch = it % NCH, c0 = ch * 8, row0 = rowbase + run * 16;
            const int sbeg = row0 < MLAT ? (row0 & ~(SEQ - 1)) : MLAT + ((row0 - MLAT) & ~(LCTX - 1));
            const int send = sbeg + (row0 < MLAT ? SEQ : LCTX);
            float w[5][8], bias[8];
#pragma unroll
            for (int t = 0; t < 5; ++t) { const f32x4 a = *(const f32x4*)(cw + t * XBW + c0), b = *(const f32x4*)(cw + t * XBW + c0 + 4);
                w[t][0] = a.x; w[t][1] = a.y; w[t][2] = a.z; w[t][3] = a.w; w[t][4] = b.x; w[t][5] = b.y; w[t][6] = b.z; w[t][7] = b.w; }
            { const f32x4 a = *(const f32x4*)(cb + c0), b = *(const f32x4*)(cb + c0 + 4); bias[0] = a.x; bias[1] = a.y; bias[2] = a.z; bias[3] = a.w; bias[4] = b.x; bias[5] = b.y; bias[6] = b.z; bias[7] = b.w; }
            v4u rows[20];
#pragma unroll
            for (int t = 0; t < 20; ++t) { const int r = row0 - 2 + t; const bool in = (r >= sbeg && r < send); const int rc = in ? r : row0; const unsigned mk = in ? 0xffffffffu : 0u;
                v4u v = __builtin_nontemporal_load((const v4u*)(PROJ + (size_t)rc * NPROJ + C_XBC + c0)); v.x &= mk; v.y &= mk; v.z &= mk; v.w &= mk; rows[t] = v; }
#pragma unroll
            for (int rr = 0; rr < 16; ++rr) {
                float acc[8];
#pragma unroll
                for (int e = 0; e < 8; ++e) acc[e] = bias[e];
#pragma unroll
                for (int t = 0; t < 5; ++t) {
#pragma unroll
                    for (int e2 = 0; e2 < 4; ++e2) { const unsigned u = rows[rr + t][e2]; acc[2 * e2] += w[t][2 * e2] * bflo(u); acc[2 * e2 + 1] += w[t][2 * e2 + 1] * bfhi(u); } }
                v4u o;
#pragma unroll
                for (int e2 = 0; e2 < 4; ++e2) o[e2] = pk2(acc[2 * e2] * __builtin_amdgcn_rcpf(1.f + __expf(-acc[2 * e2])), acc[2 * e2 + 1] * __builtin_amdgcn_rcpf(1.f + __expf(-acc[2 * e2 + 1])));
                *(v4u*)(XBC2 + (size_t)(row0 + rr) * XBW + c0) = o;
            }
        }
    }
    {
        const float* dtb = A.in[16] + layer * 12; const float* alog = A.in[17] + layer * 12;
        for (int it = gt; it < nrows * 12; it += NGT) {
            const int row = rowbase + it / 12, j = it % 12;
            const float xv = bf1(PROJ[(size_t)row * NPROJ + C_DT + j]) + dtb[j];
            const float dt = xv > 20.f ? xv : log1pf(expf(xv));
            DTLA[(size_t)row * 24 + j] = dt; DTLA[(size_t)row * 24 + 12 + j] = -dt * expf(alog[j]);
        }
    }
}
constexpr int AT_KSTR = 144, AT_VSTR = 192, AT_TK = 128, AT_KBYTES = AT_TK * AT_KSTR, AT_VBYTES = AT_TK * AT_VSTR;
constexpr float AT_THR = 6.0f;
__device__ __forceinline__ void attn_unit(LAS unsigned char* lds, const bf16* PROJ, bf16* MIXA, const float* qn, const float* kn, int b, int hq, int qrow0, int kt0, int nkt, int tid, int lane, int wave) {
    const int g = hq / 3, r32 = lane & 31, hi = lane >> 5;
    const GAS bf16* PROJg = (const GAS bf16*)PROJ; GAS bf16* MIXAg = (GAS bf16*)MIXA;
    LAS unsigned char* QP = lds + 2 * AT_KBYTES + 2 * AT_VBYTES + wave * 4096 + lane * 16;
    bf16x8 qf_in[4];
    { const GAS bf16* qp = PROJg + (size_t)(qrow0 + wave * 32 + r32) * NPROJ + C_QA + hq * 64 + hi * 8;
#pragma unroll
      for (int d0 = 0; d0 < 4; ++d0) qf_in[d0] = *(const GAS bf16x8*)(qp + d0 * 16); }
    const int lkey = tid >> 3, lch = tid & 7;
    const GAS bf16* kcol = PROJg + C_KA + g * 64 + lch * 8; const GAS bf16* vcol = PROJg + C_VA + g * 64 + lch * 8;
    LAS unsigned char* KB = lds; LAS unsigned char* VB = lds + 2 * AT_KBYTES;
    const int kwoff = lkey * AT_KSTR + lch * 16, vwoff = lkey * AT_VSTR + lch * 16;
    const int kroff = r32 * AT_KSTR + hi * 16;
    const int vroff = (4 * hi + ((lane & 15) >> 2)) * AT_VSTR + (((lane >> 4) & 1) * 16 + (lane & 3) * 4) * 2;
    float m = 0.f, lsum = 0.f; f32x16 o0, o1, negm, zero16;
#pragma unroll
    for (int r = 0; r < 16; ++r) { o0[r] = 0.f; o1[r] = 0.f; negm[r] = 0.f; zero16[r] = 0.f; }
    v4u kreg[2], vreg[2];
#define AT_LOAD(kt) do { _Pragma("unroll") for (int h2 = 0; h2 < 2; ++h2) { const int kk = (kt) * AT_TK + h2 * 64 + lkey; \
        const size_t row = kk < SEQ ? (size_t)b * SEQ + kk : (size_t)MLAT + b * LCTX + (kk - SEQ); kreg[h2] = *(const GAS v4u*)(kcol + row * NPROJ); vreg[h2] = *(const GAS v4u*)(vcol + row * NPROJ); } } while (0)
#define AT_STORE(buf) do { _Pragma("unroll") for (int h2 = 0; h2 < 2; ++h2) { *(LAS v4u*)(KB + (buf) * AT_KBYTES + h2 * 64 * AT_KSTR + kwoff) = kreg[h2]; \
        *(LAS v4u*)(VB + (buf) * AT_VBYTES + h2 * 64 * AT_VSTR + vwoff) = vreg[h2]; } } while (0)
#define AT_QK(P0, P1, Kc, DYN) do { { const bf16x8 a0 = *(const LAS bf16x8*)(Kc), a1 = *(const LAS bf16x8*)((Kc) + 32 * AT_KSTR), q = (DYN) ? *(const LAS bf16x8*)(QP) : qf_in[0]; \
            P0 = MFMA32(a0, q, (DYN) ? negm : zero16); P1 = MFMA32(a1, q, (DYN) ? negm : zero16); } \
        _Pragma("unroll") for (int d0 = 1; d0 < 4; ++d0) { const bf16x8 a0 = *(const LAS bf16x8*)((Kc) + d0 * 32), a1 = *(const LAS bf16x8*)((Kc) + 32 * AT_KSTR + d0 * 32), q = (DYN) ? *(const LAS bf16x8*)(QP + d0 * 1024) : qf_in[d0]; \
            P0 = MFMA32(a0, q, P0); P1 = MFMA32(a1, q, P1); } } while (0)
#define AT_STEP(C0, C1, N0, N1, Kn, Vc, HASN, DYN) do { if (DYN) { \
        float mxa = max3f(C0[0], C0[1], C1[0]), mxb = max3f(C0[2], C0[3], C1[1]); mxa = max3f(mxa, C1[2], C1[3]); \
        _Pragma("unroll") for (int r = 4; r < 16; r += 4) { mxa = max3f(mxa, C0[r], C0[r + 1]); mxb = max3f(mxb, C0[r + 2], C0[r + 3]); mxa = max3f(mxa, C1[r], C1[r + 1]); mxb = max3f(mxb, C1[r + 2], C1[r + 3]); } \
        float mx = max3f(mxa, mxb, mxb); mx = max3f(mx, __shfl_xor(mx, 32), mx); \
        if (first || __any(mx > AT_THR)) { const float dl = first ? mx : fmaxf(mx, 0.f); m += dl; const float alpha = __builtin_amdgcn_exp2f(-dl); \
            _Pragma("unroll") for (int r = 0; r < 16; ++r) { C0[r] -= dl; C1[r] -= dl; o0[r] *= alpha; o1[r] *= alpha; negm[r] = -m; } \
            lsum *= alpha; first = false; } } \
        if (HASN) AT_QK(N0, N1, Kn, DYN); \
        float rs = 0.f; \
        _Pragma("unroll") for (int r = 0; r < 16; ++r) { C0[r] = __builtin_amdgcn_exp2f(C0[r]); C1[r] = __builtin_amdgcn_exp2f(C1[r]); rs += C0[r] + C1[r]; } \
        lsum += rs; \
        bf16x8 pf[4]; \
        _Pragma("unroll") for (int s = 0; s < 4; ++s) { v4u w; \
            _Pragma("unroll") for (int e = 0; e < 4; ++e) { const int r = 8 * (s & 1) + 2 * e; w[e] = (s < 2) ? pk2(C0[r], C0[r + 1]) : pk2(C1[r], C1[r + 1]); } \
            pf[s] = __builtin_bit_cast(bf16x8, w); } \
        _Pragma("unroll") for (int s = 0; s < 4; ++s) { \
            const s16x4 a_lo = tr16((Vc) + (16 * s) * AT_VSTR), a_hi = tr16((Vc) + (16 * s + 8) * AT_VSTR); \
            const s16x4 b_lo = tr16((Vc) + (16 * s) * AT_VSTR + 64), b_hi = tr16((Vc) + (16 * s + 8) * AT_VSTR + 64); \
            o0 = MFMA32(CAT8(a_lo, a_hi), pf[s], o0); o1 = MFMA32(CAT8(b_lo, b_hi), pf[s], o1); } } while (0)
#define AT_FENCE __builtin_amdgcn_sched_barrier(0)
#define AT_E(C, r) do { C[r] = __builtin_amdgcn_exp2f(C[r]); C[(r) + 1] = __builtin_amdgcn_exp2f(C[(r) + 1]); } while (0)
#define AT_A(C, r, W) do { rs += C[r]; rs2 += C[(r) + 1]; W = pk2(C[r], C[(r) + 1]); } while (0)
#define AT_VRD(V, s) do { V[0] = tr16((Vc_) + (16 * (s)) * AT_VSTR); V[1] = tr16((Vc_) + (16 * (s) + 8) * AT_VSTR); V[2] = tr16((Vc_) + (16 * (s)) * AT_VSTR + 64); V[3] = tr16((Vc_) + (16 * (s) + 8) * AT_VSTR + 64); } while (0)
#define AT_STEP_S(C0, C1, N0, N1, Kn, Vc, HASN) do { \
        const LAS unsigned char* Vc_ = (Vc); bf16x8 ka[4], kb[4]; s16x4 va[4], vb[4]; v4u w0, w1, w2, w3; float rs = 0.f, rs2 = 0.f; \
        if (HASN) { _Pragma("unroll") for (int d0 = 0; d0 < 4; ++d0) { ka[d0] = *(const LAS bf16x8*)((Kn) + d0 * 32); kb[d0] = *(const LAS bf16x8*)((Kn) + 32 * AT_KSTR + d0 * 32); } } \
        AT_FENCE; AT_E(C0, 0); \
        AT_FENCE; AT_VRD(va, 0); AT_E(C0, 2); AT_A(C0, 0, w0[0]); \
        AT_FENCE; if (HASN) N0 = MFMA32(ka[0], qf_in[0], zero16); AT_E(C0, 4); AT_A(C0, 2, w0[1]); \
        AT_FENCE; if (HASN) N1 = MFMA32(kb[0], qf_in[0], zero16); AT_E(C0, 6); AT_A(C0, 4, w0[2]); \
        AT_FENCE; if (HASN) N0 = MFMA32(ka[1], qf_in[1], N0); AT_E(C0, 8); AT_A(C0, 6, w0[3]); \
        AT_FENCE; if (HASN) N1 = MFMA32(kb[1], qf_in[1], N1); AT_VRD(vb, 1); AT_E(C0, 10); AT_A(C0, 8, w1[0]); \
        AT_FENCE; o0 = MFMA32(CAT8(va[0], va[1]), __builtin_bit_cast(bf16x8, w0), o0); AT_E(C0, 12); AT_A(C0, 10, w1[1]); \
        AT_FENCE; o1 = MFMA32(CAT8(va[2], va[3]), __builtin_bit_cast(bf16x8, w0), o1); AT_E(C0, 14); AT_A(C0, 12, w1[2]); \
        AT_FENCE; if (HASN) N0 = MFMA32(ka[2], qf_in[2], N0); AT_E(C1, 0); AT_A(C0, 14, w1[3]); \
        AT_FENCE; if (HASN) N1 = MFMA32(kb[2], qf_in[2], N1); AT_VRD(va, 2); AT_E(C1, 2); AT_A(C1, 0, w2[0]); \
        AT_FENCE; o0 = MFMA32(CAT8(vb[0], vb[1]), __builtin_bit_cast(bf16x8, w1), o0); AT_E(C1, 4); AT_A(C1, 2, w2[1]); \
        AT_FENCE; o1 = MFMA32(CAT8(vb[2], vb[3]), __builtin_bit_cast(bf16x8, w1), o1); AT_E(C1, 6); AT_A(C1, 4, w2[2]); \
        AT_FENCE; if (HASN) N0 = MFMA32(ka[3], qf_in[3], N0); AT_E(C1, 8); AT_A(C1, 6, w2[3]); \
        AT_FENCE; if (HASN) N1 = MFMA32(kb[3], qf_in[3], N1); AT_VRD(vb, 3); AT_E(C1, 10); AT_A(C1, 8, w3[0]); \
        AT_FENCE; o0 = MFMA32(CAT8(va[0], va[1]), __builtin_bit_cast(bf16x8, w2), o0); AT_E(C1, 12); AT_A(C1, 10, w3[1]); \
        AT_FENCE; o1 = MFMA32(CAT8(va[2], va[3]), __builtin_bit_cast(bf16x8, w2), o1); AT_E(C1, 14); AT_A(C1, 12, w3[2]); \
        AT_FENCE; AT_A(C1, 14, w3[3]); o0 = MFMA32(CAT8(vb[0], vb[1]), __builtin_bit_cast(bf16x8, w3), o0); o1 = MFMA32(CAT8(vb[2], vb[3]), __builtin_bit_cast(bf16x8, w3), o1); lsum += rs + rs2; \
        AT_FENCE; } while (0)
    AT_LOAD(kt0);
    __syncthreads();
#pragma unroll
    for (int d0 = 0; d0 < 4; ++d0) *(LAS bf16x8*)(QP + d0 * 1024) = qf_in[d0];
    AT_STORE(0);
    if (nkt > 1) AT_LOAD(kt0 + 1);
    __syncthreads();
    bool first = true;
    f32x16 pA0, pA1, pB0, pB1;
    float Mb;
    { float gq = fabsf(((const GAS float*)qn)[lane]), gk = fabsf(((const GAS float*)kn)[lane]);
#pragma unroll
      for (int o = 1; o < 64; o <<= 1) { gq = fmaxf(gq, __shfl_xor(gq, o)); gk = fmaxf(gk, __shfl_xor(gk, o)); }
      Mb = 8.25f * LOG2E * gq * gk; }
#define AT_LOOP(DYN) do { \
    AT_QK(pA0, pA1, KB + kroff, DYN); \
    for (int t = 0; t < nkt; ++t) { \
        const int cur = t & 1; \
        if (t + 1 < nkt) AT_STORE(cur ^ 1); \
        if (t + 2 < nkt) AT_LOAD(kt0 + t + 2); \
        const LAS unsigned char* Kc = KB + cur * AT_KBYTES + kroff; const LAS unsigned char* Vc = VB + cur * AT_VBYTES + vroff; \
        AT_STEP(pA0, pA1, pB0, pB1, Kc + 64 * AT_KSTR, Vc, true, DYN); \
        __syncthreads(); \
        const LAS unsigned char* Kn = KB + (cur ^ 1) * AT_KBYTES + kroff; \
        AT_STEP(pB0, pB1, pA0, pA1, Kn, Vc + 64 * AT_VSTR, (t + 1 < nkt), DYN); \
        __syncthreads(); \
    } } while (0)
#define AT_LOOP_S() do { \
    AT_QK(pA0, pA1, KB + kroff, 0); \
    for (int t = 0; t < nkt; ++t) { \
        const int cur = t & 1; \
        if (t + 1 < nkt) AT_STORE(cur ^ 1); \
        if (t + 2 < nkt) AT_LOAD(kt0 + t + 2); \
        const LAS unsigned char* Kc = KB + cur * AT_KBYTES + kroff; const LAS unsigned char* Vc = VB + cur * AT_VBYTES + vroff; \
        AT_STEP_S(pA0, pA1, pB0, pB1, Kc + 64 * AT_KSTR, Vc, true); \
        __syncthreads(); \
        const LAS unsigned char* Kn = KB + (cur ^ 1) * AT_KBYTES + kroff; \
        AT_STEP_S(pB0, pB1, pA0, pA1, Kn, Vc + 64 * AT_VSTR, (t + 1 < nkt)); \
        __syncthreads(); \
    } } while (0)
    if (Mb < 60.f) AT_LOOP_S();
    else AT_LOOP(1);
#undef AT_LOOP
#undef AT_LOOP_S
#undef AT_STEP_S
#undef AT_E
#undef AT_A
#undef AT_VRD
#undef AT_FENCE
#undef AT_QK
#undef AT_STEP
#undef AT_LOAD
#undef AT_STORE
    lsum += __shfl_xor(lsum, 32);
    const float inv = 1.f / lsum;
    GAS bf16* op = MIXAg + (size_t)(qrow0 + wave * 32 + r32) * DM + hq * 64 + 8 * hi;
#pragma unroll
    for (int p = 0; p < 2; ++p) {
#pragma unroll
        for (int h2 = 0; h2 < 2; ++h2) {
            const int ga = 8 * p, gb = 8 * p + 4;
            unsigned ax, ay, bx, by;
            if (h2 == 0) { ax = pk2(o0[ga] * inv, o0[ga + 1] * inv); ay = pk2(o0[ga + 2] * inv, o0[ga + 3] * inv); bx = pk2(o0[gb] * inv, o0[gb + 1] * inv); by = pk2(o0[gb + 2] * inv, o0[gb + 3] * inv); }
            else         { ax = pk2(o1[ga] * inv, o1[ga + 1] * inv); ay = pk2(o1[ga + 2] * inv, o1[ga + 3] * inv); bx = pk2(o1[gb] * inv, o1[gb + 1] * inv); by = pk2(o1[gb + 2] * inv, o1[gb + 3] * inv); }
            const auto r0 = __builtin_amdgcn_permlane32_swap(ax, bx, false, false); const auto r1 = __builtin_amdgcn_permlane32_swap(ay, by, false, false);
            v4u w; w.x = r0[0]; w.y = r1[0]; w.z = r0[1]; w.w = r1[1];
            *(GAS v4u*)(op + 32 * h2 + 16 * p) = w;
        }
    }
}
template <int N>
__device__ __forceinline__ void rec_unit(LAS unsigned char* lds, int tid, int lane, int wave,
                                         const bf16* Qg, const bf16* Kg, const bf16* Vg, int pitch,
                                         const float* dtla, int dt_off, int la_off, float la_const,
                                         bf16* Yg, int ypitch, int b, bool rev, bool ctx_out) {
    constexpr int QSTR = N * 2 + 16, VSTR = 144;
    constexpr int KB_ = 128 * QSTR, VB_ = 128 * VSTR, SB_ = 64 * QSTR, FB_ = 2560;
    constexpr int OFF_K = 0, OFF_V = 2 * KB_, OFF_S = OFF_V + 2 * VB_, OFF_F = OFF_S + 2 * SB_;
    static_assert(OFF_F + 2 * FB_ <= LDSCTL_OFF, "rec_unit LDS map");
    constexpr int NT = N / 16, KS = N / 32, TPW = NT / 2, CPR = N / 8, NLD = CPR / 4;
    const int c = lane & 15, quad = lane >> 4, q4 = c >> 2, p4 = c & 3;
    const GAS bf16* Qgg = (const GAS bf16*)Qg; const GAS bf16* Kgg = (const GAS bf16*)Kg; const GAS bf16* Vgg = (const GAS bf16*)Vg; const GAS float* dtg = (const GAS float*)dtla; GAS bf16* Ygg = (GAS bf16*)Yg;
    const int own_nt = wave % NT, own_pt0 = (wave / NT) * TPW;
    const int itile = wave < 4 ? wave : 11 - wave;
    const int icol = 16 * itile + c;
    f32x4 sacc[TPW];
#pragma unroll
    for (int i = 0; i < TPW; ++i) sacc[i] = (f32x4){0.f, 0.f, 0.f, 0.f};
    v4u rk[NLD], rv[2]; bf16x8 qn[KS]; float la0 = la_const, la1 = la_const, s0 = 1.f, s1 = 1.f;
#define RC_GEOM(ci_) const bool isctx_ = (ci_) < 2; const int cc_ = isctx_ ? (ci_) : (ci_) - 2; const int sbase_ = isctx_ ? MLAT + b * LCTX : b * SEQ, slen_ = isctx_ ? LCTX : SEQ; \
        const int pos0_ = rev ? (slen_ - 1 - cc_ * 128) : cc_ * 128, pstep_ = rev ? -1 : 1;
#define RC_LOAD(ci_) do { RC_GEOM(ci_) \
        _Pragma("unroll") for (int k = 0; k < NLD; ++k) { const int idx = tid + k * 512, ip = idx / CPR, ch = idx % CPR; const size_t row = (size_t)(sbase_ + pos0_ + pstep_ * ip); \
            rk[k] = *(const GAS v4u*)(Kgg + row * pitch + ch * 8); } \
        _Pragma("unroll") for (int k = 0; k < 2; ++k) { const int idx = tid + k * 512, ip = idx >> 3, ch = idx & 7; const size_t row = (size_t)(sbase_ + pos0_ + pstep_ * ip); \
            rv[k] = *(const GAS v4u*)(Vgg + row * pitch + ch * 8); } \
        { const GAS bf16* qp = Qgg + (size_t)(sbase_ + pos0_ + pstep_ * icol) * pitch + quad * 8; \
          _Pragma("unroll") for (int ks = 0; ks < KS; ++ks) qn[ks] = *(const GAS bf16x8*)(qp + ks * 32); } \
        if (wave == 0 && dtla) { const size_t r0 = (size_t)(sbase_ + pos0_ + pstep_ * (2 * lane)), r1 = (size_t)(sbase_ + pos0_ + pstep_ * (2 * lane + 1)); \
            la0 = dtg[r0 * 24 + la_off]; la1 = dtg[r1 * 24 + la_off]; s0 = dtg[r0 * 24 + dt_off]; s1 = dtg[r1 * 24 + dt_off]; } } while (0)
#define RC_STORE(bf_) do { \
        _Pragma("unroll") for (int k = 0; k < NLD; ++k) { const int idx = tid + k * 512, ip = idx / CPR, ch = idx % CPR; *(LAS v4u*)(lds + OFF_K + (bf_) * KB_ + ip * QSTR + ch * 16) = rk[k]; } \
        _Pragma("unroll") for (int k = 0; k < 2; ++k) { const int idx = tid + k * 512, ip = idx >> 3, ch = idx & 7; *(LAS v4u*)(lds + OFF_V + (bf_) * VB_ + ip * VSTR + ch * 16) = rv[k]; } } while (0)
#define RC_CUM(bf_) do { if (wave == 0) { LAS float* CUMw = (LAS float*)(lds + OFF_F + (bf_) * FB_); \
            const float pair = la0 + la1; float v = pair; \
            _Pragma("unroll") for (int o = 1; o < 64; o <<= 1) { const float t = __shfl_up(v, o); if (lane >= o) v += t; } \
            const float c1 = v, c0 = (v - pair) + la0, last = __shfl(v, 63); \
            CUMw[2 * lane] = c0 * LOG2E; CUMw[2 * lane + 1] = c1 * LOG2E; \
            CUMw[128 + 2 * lane] = __expf(c0); CUMw[128 + 2 * lane + 1] = __expf(c1); \
            CUMw[256 + 2 * lane] = s0 * __expf(last - c0); CUMw[256 + 2 * lane + 1] = s1 * __expf(last - c1); \
            CUMw[384 + 2 * lane] = s0; CUMw[384 + 2 * lane + 1] = s1; \
            if (lane == 0) CUMw[512] = __expf(last); } } while (0)
    RC_LOAD(0);
    __syncthreads();
    for (int i = tid; i < SB_ / 4; i += NWAVES * 64) ((LAS unsigned*)(lds + OFF_S))[i] = 0u;
    RC_STORE(0); RC_CUM(0);
    bf16x8 qf[KS];
#pragma unroll
    for (int ks = 0; ks < KS; ++ks) qf[ks] = qn[ks];
    RC_LOAD(1);
    __syncthreads();
    for (int ci = 0; ci < 18; ++ci) {
        RC_GEOM(ci)
        const int cur = ci & 1;
        const LAS unsigned char* Kc = lds + OFF_K + cur * KB_; const LAS unsigned char* Vc = lds + OFF_V + cur * VB_; const LAS unsigned char* Sc = lds + OFF_S + cur * SB_;
        const LAS float* CUM = (const LAS float*)(lds + OFF_F + cur * FB_); const LAS float* ECUM = CUM + 128; const LAS float* WJ = CUM + 256; const LAS float* SJ = CUM + 384;
        const float cum_i = CUM[icol], ecum_i = ECUM[icol];
        const bool want_y = !isctx_ || ctx_out;
        if (want_y) {
            f32x4 ya[4];
            {   bf16x8 sf[4][KS];
#pragma unroll
                for (int pt = 0; pt < 4; ++pt)
#pragma unroll
                    for (int ks = 0; ks < KS; ++ks) sf[pt][ks] = *(const LAS bf16x8*)(Sc + (16 * pt + c) * QSTR + ks * 64 + quad * 16);
#pragma unroll
                for (int pt = 0; pt < 4; ++pt) ya[pt] = (f32x4){0.f, 0.f, 0.f, 0.f};
#pragma unroll
                for (int ks = 0; ks < KS; ++ks)
#pragma unroll
                    for (int pt = 0; pt < 4; ++pt) ya[pt] = MFMA16(sf[pt][ks], qf[ks], ya[pt]);
#pragma unroll
                for (int pt = 0; pt < 4; ++pt) ya[pt] = ya[pt] * ecum_i; }
            const int nkk = (itile >> 1) + 1;
#define RC_YSTEPS(NKK) do { \
            _Pragma("unroll") for (int kk = 0; kk < (NKK); ++kk) { \
                bf16x8 ka[2][KS]; \
                _Pragma("unroll") for (int half = 0; half < 2; ++half) \
                    _Pragma("unroll") for (int ks = 0; ks < KS; ++ks) ka[half][ks] = *(const LAS bf16x8*)(Kc + (32 * kk + 16 * half + c) * QSTR + ks * 64 + quad * 16); \
                f32x4 cj[2], sj[2]; \
                _Pragma("unroll") for (int half = 0; half < 2; ++half) { cj[half] = *(const LAS f32x4*)(CUM + 32 * kk + 16 * half + 4 * quad); sj[half] = *(const LAS f32x4*)(SJ + 32 * kk + 16 * half + 4 * quad); } \
                s16x4 vlo[4], vhi[4]; \
                _Pragma("unroll") for (int pt = 0; pt < 4; ++pt) { const LAS unsigned char* vp = Vc + (32 * kk + 4 * quad + q4) * VSTR + (16 * pt + 4 * p4) * 2; vlo[pt] = tr16(vp); vhi[pt] = tr16(vp + 16 * VSTR); } \
                f32x4 g0 = (f32x4){0.f, 0.f, 0.f, 0.f}, g1 = (f32x4){0.f, 0.f, 0.f, 0.f}; \
                _Pragma("unroll") for (int ks = 0; ks < KS; ++ks) { g0 = MFMA16(ka[0][ks], qf[ks], g0); g1 = MFMA16(ka[1][ks], qf[ks], g1); } \
                v4u w; \
                _Pragma("unroll") for (int half = 0; half < 2; ++half) { const f32x4 gacc = half ? g1 : g0; float pv[4]; \
                    _Pragma("unroll") for (int r = 0; r < 4; ++r) { const int j = 32 * kk + 16 * half + 4 * quad + r; const bool ok = rev ? (j < icol) : (j <= icol); \
                        const float e = __builtin_amdgcn_exp2f(fminf(cum_i - cj[half][r], 0.f)); pv[r] = ok ? gacc[r] * sj[half][r] * e : 0.f; } \
                    w[2 * half] = pk2(pv[0], pv[1]); w[2 * half + 1] = pk2(pv[2], pv[3]); } \
                const bf16x8 pfr = __builtin_bit_cast(bf16x8, w); \
                _Pragma("unroll") for (int pt = 0; pt < 4; ++pt) ya[pt] = MFMA16(CAT8(vlo[pt], vhi[pt]), pfr, ya[pt]); \
            } } while (0)
            if (nkk == 4) RC_YSTEPS(4); else if (nkk == 3) RC_YSTEPS(3); else if (nkk == 2) RC_YSTEPS(2); else RC_YSTEPS(1);
#undef RC_YSTEPS
            GAS bf16* yp = Ygg + (size_t)(sbase_ + pos0_ + pstep_ * icol) * ypitch + 4 * quad;
#pragma unroll
            for (int pt = 0; pt < 4; ++pt) { v2u w; w.x = pk2(ya[pt][0], ya[pt][1]); w.y = pk2(ya[pt][2], ya[pt][3]); *(GAS v2u*)(yp + 16 * pt) = w; }
        }
        if (ci + 1 < 18) { RC_STORE(cur ^ 1); RC_CUM(cur ^ 1);
#pragma unroll
            for (int ks = 0; ks < KS; ++ks) qf[ks] = qn[ks];
            if (ci + 2 < 18) RC_LOAD(ci + 2); }
        { const float dec = CUM[512];
#pragma unroll
          for (int i = 0; i < TPW; ++i) sacc[i] = sacc[i] * dec;
#pragma unroll
          for (int kk = 0; kk < 4; ++kk) {
              const LAS unsigned char* kp = Kc + (32 * kk + 8 * quad + q4) * QSTR + (16 * own_nt + 4 * p4) * 2;
              const s16x4 klo = tr16(kp), khi = tr16(kp + 4 * QSTR);
              const f32x4 w0 = *(const LAS f32x4*)(WJ + 32 * kk + 8 * quad), w1 = *(const LAS f32x4*)(WJ + 32 * kk + 8 * quad + 4);
              v4u kw; kw.x = pk2(bf1((bf16)klo[0]) * w0[0], bf1((bf16)klo[1]) * w0[1]); kw.y = pk2(bf1((bf16)klo[2]) * w0[2], bf1((bf16)klo[3]) * w0[3]);
              kw.z = pk2(bf1((bf16)khi[0]) * w1[0], bf1((bf16)khi[1]) * w1[1]); kw.w = pk2(bf1((bf16)khi[2]) * w1[2], bf1((bf16)khi[3]) * w1[3]);
              const bf16x8 kb = __builtin_bit_cast(bf16x8, kw);
#pragma unroll
              for (int i = 0; i < TPW; ++i) { const LAS unsigned char* vp = Vc + (32 * kk + 8 * quad + q4) * VSTR + (16 * (own_pt0 + i) + 4 * p4) * 2;
                  const s16x4 lo = tr16(vp), hi = tr16(vp + 4 * VSTR); sacc[i] = MFMA16(CAT8(lo, hi), kb, sacc[i]); }
          } }
#pragma unroll
        for (int i = 0; i < TPW; ++i)
#pragma unroll
            for (int r = 0; r < 4; ++r) *(LAS bf16*)(lds + OFF_S + (cur ^ 1) * SB_ + (16 * (own_pt0 + i) + 4 * quad + r) * QSTR + (16 * own_nt + c) * 2) = (bf16)f2bf(sacc[i][r]);
        __syncthreads();
    }
#undef RC_GEOM
#undef RC_LOAD
#undef RC_STORE
#undef RC_CUM
}
__device__ __forceinline__ void finish_rows(const Args& A, unsigned char* ws, int layer, int m0, int m1, int mstep, int lane) {
    const bf16* PROJ = (const bf16*)(ws + WS_BIG); const bf16* XBC2 = (const bf16*)(ws + WS_XBC2);
    bf16* MIXA = (bf16*)(ws + WS_XN);
    const int Mrows = layer == 0 ? MALL : MLAT;
    const bf16* Yret = (const bf16*)A.out; const bf16* Yssd = Yret + (size_t)2 * Mrows * 256;
    const f32x4 gg = *(const f32x4*)(A.in[12] + layer * 256 + 4 * lane), gb = *(const f32x4*)(A.in[13] + layer * 256 + 4 * lane);
    const int l8 = lane < 48 ? lane : 0;
    const float dsk = A.in[18][layer * 6 + (l8 >> 3)];
    const f32x4 ng0 = *(const f32x4*)(A.in[19] + layer * 384 + 8 * l8), ng1 = *(const f32x4*)(A.in[19] + layer * 384 + 8 * l8 + 4);
#pragma unroll 2
    for (int m = m0; m < m1; m += mstep) {
        {
            const v2u a = __builtin_nontemporal_load((const v2u*)(Yret + (size_t)m * 256 + 4 * lane)), bq = __builtin_nontemporal_load((const v2u*)(Yret + ((size_t)Mrows + m) * 256 + 4 * lane));
            const v2u gq = __builtin_nontemporal_load((const v2u*)(PROJ + (size_t)m * NPROJ + C_GR + 4 * lane));
            float y[4] = {bflo(a.x) + bflo(bq.x), bfhi(a.x) + bfhi(bq.x), bflo(a.y) + bflo(bq.y), bfhi(a.y) + bfhi(bq.y)};
            const float gv[4] = {bflo(gq.x), bfhi(gq.x), bflo(gq.y), bfhi(gq.y)};
            const float mu = sum16((y[0] + y[1]) + (y[2] + y[3])) * (1.f / 64.f);
            float d[4], q = 0.f;
#pragma unroll
            for (int e = 0; e < 4; ++e) { d[e] = y[e] - mu; q += d[e] * d[e]; }
            const float rstd = rsqrtf(sum16(q) * (1.f / 64.f) + EPS);
            float o[4];
#pragma unroll
            for (int e = 0; e < 4; ++e) o[e] = (d[e] * rstd * gg[e] + gb[e]) * silu_f(gv[e]);
            v2u w; w.x = pk2(o[0], o[1]); w.y = pk2(o[2], o[3]); *(v2u*)(MIXA + (size_t)m * DM + 384 + 4 * lane) = w;
        }
        {
            float u[8]; float ss = 0.f;
            if (lane < 48) {
                const v4u a = __builtin_nontemporal_load((const v4u*)(Yssd + (size_t)m * 384 + 8 * lane)), bq = __builtin_nontemporal_load((const v4u*)(Yssd + ((size_t)Mrows + m) * 384 + 8 * lane));
                const v4u xs = __builtin_nontemporal_load((const v4u*)(XBC2 + (size_t)m * XBW + 8 * lane)), z = __builtin_nontemporal_load((const v4u*)(PROJ + (size_t)m * NPROJ + C_Z + 8 * lane));
#pragma unroll
                for (int e2 = 0; e2 < 4; ++e2) { const float y0 = bflo(a[e2]) + bflo(bq[e2]) + dsk * bflo(xs[e2]), y1 = bfhi(a[e2]) + bfhi(bq[e2]) + dsk * bfhi(xs[e2]);
                    u[2 * e2] = y0 * silu_f(bflo(z[e2])); u[2 * e2 + 1] = y1 * silu_f(bfhi(z[e2])); ss += u[2 * e2] * u[2 * e2] + u[2 * e2 + 1] * u[2 * e2 + 1]; }
            } else {
#pragma unroll
                for (int e = 0; e < 8; ++e) u[e] = 0.f;
            }
            const float rstd = rsqrtf(wave_sum(ss) * (1.f / 384.f) + EPS);
            if (lane < 48) { v4u w; w.x = pk2(u[0] * rstd * ng0[0], u[1] * rstd * ng0[1]); w.y = pk2(u[2] * rstd * ng0[2], u[3] * rstd * ng0[3]);
                w.z = pk2(u[4] * rstd * ng1[0], u[5] * rstd * ng1[1]); w.w = pk2(u[6] * rstd * ng1[2], u[7] * rstd * ng1[3]);
                *(v4u*)(MIXA + (size_t)m * DM + 640 + 8 * lane) = w; }
        }
    }
}

constexpr int U_SSD = 96, U_RET = 64, U_ATT = 384, U_CATT = 48, FIN_ROWS = 32;
__device__ __forceinline__ void mixer_phase(Frame& F, const Args& A, int layer, int rep) {
    const bool ctx_out = layer == 0; const int Mrows = ctx_out ? MALL : MLAT;
    const int n_mix = U_SSD + U_RET + U_ATT + (ctx_out ? U_CATT : 0), total = n_mix + Mrows / FIN_ROWS;
    gu32* recdone = F.ctl + CW_FLAGS + 64 * 8 * (layer + 2 * rep);
    gu32* qword = F.ctl + CW_QUEUE + 64 * layer + 128 * rep;
    for (;;) {
        if (F.tid == 0) F.MISC[16] = __hip_atomic_fetch_add(qword, 1u, RLX_AGENT);
        __syncthreads();
        const int uq = (int)F.MISC[16];
        __syncthreads();
#ifdef REP_ONLY_REC
        if (rep > 0 && (uq >= U_SSD + U_RET && uq < n_mix)) continue;
#endif
#ifdef REP_ONLY_ATT
        if (rep > 0 && (uq < U_SSD + U_RET || uq >= n_mix)) continue;
#endif
        if (uq >= total) break;
        int tid = F.tid; asm volatile("" : "+v"(tid));
        const int lane = tid & 63, wave = __builtin_amdgcn_readfirstlane(tid >> 6);
        unsigned char* wsb = A.ws; asm volatile("" : "+s"(wsb));
        const int u = uq;
        const bf16* PROJ = (const bf16*)(wsb + WS_BIG); const bf16* XBC2 = (const bf16*)(wsb + WS_XBC2); const float* DTLA = (const float*)(wsb + WS_DTLA);
        bf16* MIXA = (bf16*)(wsb + WS_XN);
        bf16* Yret = (bf16*)A.out; bf16* Yssd = Yret + (size_t)2 * Mrows * 256;
#define REC_PUBLISH(b_) do { asm volatile("s_waitcnt vmcnt(0)" ::: "memory"); __syncthreads(); \
            if (tid == 0) { __builtin_amdgcn_fence(__ATOMIC_RELEASE, "agent"); asm volatile("s_waitcnt vmcnt(0)" ::: "memory"); __hip_atomic_fetch_add(recdone + 64 * (b_), 1u, RLX_AGENT); } } while (0)
        if (u >= n_mix) {
            const int row0 = (u - n_mix) * FIN_ROWS, b = row0 < MLAT ? row0 >> 11 : (row0 - MLAT) >> 8;
            if (tid == 0) { unsigned sp = 0; while (__hip_atomic_load(recdone + 64 * b, RLX_AGENT) < 20u && ++sp < (1u << 24)) __builtin_amdgcn_s_sleep(4);
                __builtin_amdgcn_fence(__ATOMIC_ACQUIRE, "agent"); asm volatile("s_waitcnt vmcnt(0)" ::: "memory"); }
            __syncthreads();
            finish_rows(A, wsb, layer, row0 + wave, row0 + FIN_ROWS, NWAVES, lane);
            continue;
        }
        if (u < U_SSD) {
            const int b = u / 12, h = (u % 12) >> 1, dir = u & 1, g = h / 3;
            rec_unit<128>(F.lds, tid, lane, wave, XBC2 + 640 + g * 128, XBC2 + 384 + g * 128, XBC2 + h * 64, XBW,
                          DTLA, dir * 6 + h, 12 + dir * 6 + h, 0.f, Yssd + (size_t)dir * Mrows * 384 + h * 64, 384, b, dir == 1, ctx_out);
            REC_PUBLISH(b);
        } else if (u < U_SSD + U_RET) {
            const int v = u - U_SSD, b = v >> 3, h = (v & 7) >> 1, dir = v & 1;
            const float dl = A.in[11][layer * 8 + dir * 4 + h];
            const float lg = fminf(dl, 0.f) - log1pf(expf(-fabsf(dl)));
            rec_unit<64>(F.lds, tid, lane, wave, PROJ + C_QR + h * 64, PROJ + C_KR + h * 64, PROJ + C_VR + h * 64, NPROJ,
                         nullptr, 0, 0, lg, Yret + (size_t)dir * Mrows * 256 + h * 64, 256, b, dir == 1, ctx_out);
            REC_PUBLISH(b);
        } else {
            const int v = u - U_SSD - U_RET; const bool isc = v >= U_ATT; const int vc = v - U_ATT;
            const int b = isc ? vc / 6 : v / 48, hq = isc ? vc % 6 : (v % 48) >> 3, qb = v & 7;
            attn_unit(F.lds, PROJ, MIXA, A.in[9] + layer * 64, A.in[10] + layer * 64, b, hq, isc ? MLAT + b * LCTX : b * SEQ + qb * 256, isc ? 16 : 0, isc ? 2 : 18, tid, lane, wave);
        }
    }
}
#ifndef PH_MASK
#define PH_MASK 0xFFFFF
#endif
#define IN(k) (((PH_MASK >> ((k) > 9 ? (k) - 9 : (k))) & 1) && lo <= (k) && (k) < hi)
#ifndef REP_X
#define REP_X 0
#endif
#ifndef REP_GSEL
#define REP_GSEL 0
#endif
#define MKFRAME() Frame F; { int t_ = threadIdx.x; asm volatile("" : "+v"(t_)); F.tid = t_; F.lane = t_ & 63; F.wave = __builtin_amdgcn_readfirstlane(t_ >> 6); F.lds = ldsb; \
    F.MISC = (volatile LAS unsigned*)(ldsb + MISC_OFF); F.ctl = (gu32*)(args.ws + WS_CTL); F.G = gridDim.x; const int bx_ = blockIdx.x; F.vcu = (F.G % 8 == 0) ? (bx_ % 8) * (F.G / 8) + bx_ / 8 : bx_; }
#define SEAM(k) do { if (IN((k) + 1)) xcd_barrier(bar); } while (0)
#define NG (args.in[6] + (size_t)layer * 4 * DM)
#define MODL (MOD + (size_t)layer * 9 * 6144)
#define MOD ((float*)(args.ws + WS_MOD))
#define XN ((bf16*)(args.ws + WS_XN))
#define BIG ((bf16*)(args.ws + WS_BIG))
#define XC ((float*)(args.ws + WS_XC))
#define Win_t ((const bf16*)(args.ws + WS_WIN))
#define Wout_t ((const bf16*)(args.ws + WS_WOUT))
#define W1_t ((const bf16*)(args.ws + WS_W1))
#define W2_t ((const bf16*)(args.ws + WS_W2))
#define SLAB ((bf16*)args.out)
#define XB ((bf16*)(args.ws + WS_XB))
template <int layer>
__device__ __forceinline__ void layer_body(LAS unsigned char* ldsb, const Args& args, const XcdBarrier& bar, const int lo, const int hi) {
        const int pb = 1 + 9 * layer; const int Mrows = layer == 0 ? MALL : MLAT;

        if (IN(pb + 0)) { MKFRAME();
            RowPass P;
            if (layer == 0) P = RowPass{args.in[0], args.in[2], nullptr, nullptr, nullptr, XN, nullptr, nullptr, NG, MODL + 1024, MODL, MALL, nullptr};
            else { P = RowPass{XB, XC, XN, XB, nullptr, XN, MOD + 5120, args.in[6] + 3 * DM, NG, MODL + 1024, MODL, MALL, SLAB}; }
            row_pass<layer, 1, true>(F, P);
#if (REP_X & 2)
            if (layer == 0) { xcd_barrier(bar); row_pass<layer, 1, true>(F, P); }
#endif
            SEAM(pb + 0);
        }
        if (IN(pb + 1)) { MKFRAME();
            pg8::Gemm g{XN, Win_t, MALL, NPROJ, DM, DM}; pg8::StaticOrder S; S.init(MALL, NPROJ, F.G, (int)blockIdx.x, DM / 64);
            fill_rope_table(F);
            EpiProj E{BIG, args.in[9] + layer * 64, args.in[10] + layer * 64, (const LAS float*)(F.lds + ROPE_LDS_OFF)};
            pg8::gemm_phase<EpiProj, pg8::StaticOrder, true, true>(F.lds + RING_OFF, g, S, E);
#if (REP_GSEL & 1)
            xcd_barrier(bar); pg8::gemm_phase<EpiProj, pg8::StaticOrder, true, true>(F.lds + RING_OFF, g, S, E);
#endif
            convert_weights(F, args, layer, 1);
            SEAM(pb + 1);
        }
        if (IN(pb + 2)) { MKFRAME(); prep_rows(args, args.ws, layer, 0, MALL, F.vcu * (NWAVES * 64) + F.tid, F.G * NWAVES * 64);
#if (REP_X & 16)
            xcd_barrier(bar); prep_rows(args, args.ws, layer, 0, MALL, F.vcu * (NWAVES * 64) + F.tid, F.G * NWAVES * 64);
#endif
            SEAM(pb + 2); }
        if (IN(pb + 3)) { MKFRAME(); mixer_phase(F, args, layer, 0);
#ifdef REP_D
            for (int rep = 1; rep <= REP_D; ++rep) { xcd_barrier(bar); mixer_phase(F, args, layer, rep); }
#endif
            if (IN(pb + 5)) xcd_barrier(bar); }
        if (IN(pb + 5)) { MKFRAME();
            pg8::Gemm g{XN, Wout_t, Mrows, DM, DM, DM}; pg8::StaticOrder S; S.init(MLAT, DM, F.G, (int)blockIdx.x, DM / 64);
            pg8::EpiStore<0> E{BIG, DM, SLAB, (size_t)MCTX * DM, MLAT};
            if constexpr (layer == 0) {
                pg8::SplitKOrder K; K.init(MLAT / 256, MCTX / 256, DM / 256, 8, DM / 8, F.G, (int)blockIdx.x); pg8::ComboOrder C; C.init(S, K);
                pg8::gemm_phase<pg8::EpiStore<0>, pg8::ComboOrder, true, true>(F.lds + RING_OFF, g, C, E);
            } else pg8::gemm_phase<pg8::EpiStore<0>, pg8::StaticOrder, true, true>(F.lds + RING_OFF, g, S, E);
#if (REP_GSEL & 2)
            xcd_barrier(bar); if constexpr (layer == 0) {
                pg8::SplitKOrder K; K.init(MLAT / 256, MCTX / 256, DM / 256, 8, DM / 8, F.G, (int)blockIdx.x); pg8::ComboOrder C; C.init(S, K);
                pg8::gemm_phase<pg8::EpiStore<0>, pg8::ComboOrder, true, true>(F.lds + RING_OFF, g, C, E);
            } else pg8::gemm_phase<pg8::EpiStore<0>, pg8::StaticOrder, true, true>(F.lds + RING_OFF, g, S, E);
#endif
            SEAM(pb + 5);
        }
        if (IN(pb + 6)) { MKFRAME();
            RowPass P{layer == 0 ? (const void*)args.in[0] : (const void*)XB, layer == 0 ? args.in[2] : XC, BIG, XB, layer == 0 ? XC : nullptr, XN, MODL + 2048, NG + DM, NG + 2 * DM, MODL + 4096, MODL + 3072, Mrows, layer == 0 ? SLAB : nullptr};
            row_pass<layer, 1>(F, P);
#if (REP_X & 8)
            if (layer == 0) { xcd_barrier(bar); row_pass<layer, 1>(F, P); }
#endif
            SEAM(pb + 6);
        }
        if (IN(pb + 7)) { MKFRAME();
            pg8::Gemm g{XN, W1_t, Mrows, DFF, DM, DM}; pg8::StaticOrder S; S.init(Mrows, DFF, F.G, (int)blockIdx.x, DM / 64);
            pg8::EpiStore<2> E{BIG, DFF, nullptr, 0, 0};
            pg8::gemm_phase<pg8::EpiStore<2>, pg8::StaticOrder, true, true>(F.lds + RING_OFF, g, S, E);
            if constexpr (layer == 0) convert_weights(F, args, 1, 2);
#if (REP_GSEL & 4)
            xcd_barrier(bar); pg8::gemm_phase<pg8::EpiStore<2>, pg8::StaticOrder, true, true>(F.lds + RING_OFF, g, S, E);
#endif
            SEAM(pb + 7);
        }
        if (IN(pb + 8)) { MKFRAME();
            pg8::Gemm g{BIG, W2_t, Mrows, DM, DFF, DFF}; pg8::StaticOrder S; S.init(MLAT, DM, F.G, (int)blockIdx.x, DFF / 64);
            pg8::EpiStore<0> E{XN, DM, SLAB, (size_t)MCTX * DM, MLAT};
            if constexpr (layer == 0) {
                pg8::SplitKOrder K; K.init(MLAT / 256, MCTX / 256, DM / 256, 8, DFF / 8, F.G, (int)blockIdx.x); pg8::ComboOrder C; C.init(S, K);
                pg8::gemm_phase<pg8::EpiStore<0>, pg8::ComboOrder, true, true>(F.lds + RING_OFF, g, C, E);
            } else pg8::gemm_phase<pg8::EpiStore<0>, pg8::StaticOrder, true, true>(F.lds + RING_OFF, g, S, E);
#if (REP_GSEL & 8)
            xcd_barrier(bar); if constexpr (layer == 0) {
                pg8::SplitKOrder K; K.init(MLAT / 256, MCTX / 256, DM / 256, 8, DFF / 8, F.G, (int)blockIdx.x); pg8::ComboOrder C; C.init(S, K);
                pg8::gemm_phase<pg8::EpiStore<0>, pg8::ComboOrder, true, true>(F.lds + RING_OFF, g, C, E);
            } else pg8::gemm_phase<pg8::EpiStore<0>, pg8::StaticOrder, true, true>(F.lds + RING_OFF, g, S, E);
#endif
            SEAM(pb + 8);
        }
    }
__global__ void __launch_bounds__(NWAVES * 64, 2) fwd_kernel(Args args) {
    extern __shared__ __attribute__((aligned(16))) unsigned char lds[];
    LAS unsigned char* ldsb = (LAS unsigned char*)lds;
    for (int u = threadIdx.x; u < (LDS_BYTES - LDSCTL_OFF) / 4; u += NWAVES * 64) ((LAS unsigned*)(ldsb + LDSCTL_OFF))[u] = 0u;
    __syncthreads();
    XcdBarrier bar; bar.bar = (unsigned*)((gu32*)(args.ws + WS_CTL) + CW_BAR); bar.x = 0; bar.st = nullptr;
    if (!MK_PER_PHASE) bar = xcd_barrier_post((unsigned*)((gu32*)(args.ws + WS_CTL) + CW_BAR), (volatile LAS unsigned*)(ldsb + MISC_OFF) + 8);
    const int lo = args.ph_lo, hi = args.ph_hi;

    if (IN(0)) { MKFRAME(); mod_phase(F, args); convert_weights(F, args, 0, 0);
        SEAM(0); }
    layer_body<0>(ldsb, args, bar, lo, hi);
    layer_body<1>(ldsb, args, bar, lo, hi);
#ifdef REP_BAR
    for (int rb = 0; rb < REP_BAR; ++rb) xcd_barrier(bar);
#endif
    if (IN(19)) { MKFRAME();
        RowPass P{XB, XC, XN, args.out, nullptr, nullptr, MOD + 9 * 6144 + 5120, args.in[6] + 7 * DM, nullptr, nullptr, nullptr, MLAT, nullptr};
        row_pass<1, 0>(F, P);
    }
}

extern "C" void kernel_launch(void* const* d_in, const int* in_sizes, int n_in, void* d_out, int out_size, void* d_ws, size_t ws_size, hipStream_t stream) {
    static int grid = 0;
    if (grid == 0) {
        if (n_in != 22 || in_sizes[0] != MLAT * DM || out_size != MLAT * DM || ws_size < WS_END) {
            fprintf(stderr, "kernel_launch: unexpected shapes: n_in %d in0 %d out %d ws %zu; nothing launched\n", n_in, n_in > 0 ? in_sizes[0] : -1, out_size, ws_size); grid = -1; return; }
        int dev = 0, cus = 0, per_cu = 0;
        if (hipGetDevice(&dev) != hipSuccess || hipDeviceGetAttribute(&cus, hipDeviceAttributeMultiprocessorCount, dev) != hipSuccess) { grid = -1; return; }
        if (hipFuncSetAttribute((const void*)fwd_kernel, hipFuncAttributeMaxDynamicSharedMemorySize, LDS_BYTES) != hipSuccess) { fprintf(stderr, "kernel_launch: hipFuncSetAttribute failed\n"); grid = -1; return; }
        if (hipOccupancyMaxActiveBlocksPerMultiprocessor(&per_cu, (const void*)fwd_kernel, NWAVES * 64, LDS_BYTES) != hipSuccess || per_cu < 1)
            fprintf(stderr, "kernel_launch: note: occupancy query reports %d workgroups per CU\n", per_cu);
        (void)hipGetLastError();
        grid = cus;
    }
    if (grid < 0) return;
    if (hipMemsetAsync((char*)d_ws + WS_CTL, 0, CTL_ZERO_BYTES, stream) != hipSuccess) { fprintf(stderr, "kernel_launch: memset failed\n"); return; }
    Args a{};
    for (int i = 0; i < 22; ++i) a.in[i] = (const float*)d_in[i];
    a.out = (float*)d_out; a.ws = (unsigned char*)d_ws;
#if MK_PER_PHASE
    for (int ph = 0; ph < N_PHASES; ++ph) { a.ph_lo = ph; a.ph_hi = ph + 1; a.li = ph;
        hipLaunchKernelGGL(fwd_kernel, dim3(grid), dim3(NWAVES * 64), LDS_BYTES, stream, a); }
#else
    a.ph_lo = 0; a.ph_hi = N_PHASES; a.li = 0;
    hipLaunchKernelGGL(fwd_kernel, dim3(grid), dim3(NWAVES * 64), LDS_BYTES, stream, a);
#endif
    const hipError_t le = hipPeekAtLastError();
    if (le != hipSuccess) fprintf(stderr, "kernel_launch: launch failed: %s\n", hipGetErrorName(le));
}
```

```cpp
#include <hip/hip_runtime.h>
#include <hip/hip_bf16.h>
#include <cstdio>
#include <cstdint>
#ifndef MK_PER_PHASE
#define MK_PER_PHASE 0
#endif
namespace pg8 {
#define PG8_LAS __attribute__((address_space(3)))
typedef unsigned short bf16_t;
typedef short bf16x8 __attribute__((ext_vector_type(8)));
typedef float f32x4 __attribute__((ext_vector_type(4)));
typedef unsigned u32x4 __attribute__((ext_vector_type(4)));
constexpr int BM = 256, BK = 64, HALF = 128, HTB = HALF * BK * 2  , STAGE_BYTES = 8 * HTB, NXCD = 8, WGM = 4;

__host__ __device__ __forceinline__ int lds_byte(int r, int c) { const int st = (r >> 4) * 2 + (c >> 5), rr = r & 15, cc = c & 31, ob = rr * 64 + cc * 2; return st * 1024 + (ob ^ (((ob >> 9) & 1) << 5)); }
__host__ __device__ __forceinline__ void stage_rc(int b, int& R, int& C) { const int st = b / 1024, sb = b % 1024, swz = sb ^ (((sb >> 9) & 1) << 5); R = (st >> 1) * 16 + swz / 64; C = (st & 1) * 32 + (swz % 64) / 2; }
__host__ __device__ __forceinline__ int perm32(int rho) { const int n = rho >> 4, i = rho & 15; return 8 * (i >> 2) + 4 * n + (i & 3); }

struct Unit { int pm, pn, ko, ks, nkt; };
struct Gemm { const bf16_t* A; const bf16_t* Bt; int M, N, K, ld; };

struct StaticOrder {
    int nM, nN, nwg, G, c, nkt;
    __host__ __device__ void init(int M, int N, int G_, int c_, int nkt_) { nM = M / BM; nN = N / BM; nwg = nM * nN; G = G_; c = c_; nkt = nkt_; }
    __host__ __device__ bool next(int i, Unit& u) const {
        const long L = (long)i * G + c; if (L >= nwg) return false;
        int wgid = (int)L; { const int q = nwg / NXCD, r = nwg % NXCD, xcd = wgid % NXCD, off = wgid / NXCD; wgid = (xcd < r ? xcd * (q + 1) : r * (q + 1) + (xcd - r) * q) + off; }
        const int nig = WGM * nN, gid = wgid / nig, fm = gid * WGM, gsz = (nM - fm) < WGM ? (nM - fm) : WGM;
        u.pm = fm + ((wgid % nig) % gsz); u.pn = (wgid % nig) / gsz; u.ko = 0; u.ks = -1; u.nkt = nkt; return true;
    }
    __device__ __forceinline__ void a_ready(const Unit&) const {}
    __device__ __forceinline__ void done(const Unit&) const {}
};

struct SplitKOrder {
    int pm0, npm, nN, nks, kslice, G, c;
    __host__ __device__ void init(int pm0_, int npm_, int nN_, int nks_, int kslice_, int G_, int c_) { pm0 = pm0_; npm = npm_; nN = nN_; nks = nks_; kslice = kslice_; G = G_; c = c_; }
    __host__ __device__ bool next(int i, Unit& u) const {
        const long L = (long)i * G + c; if (L >= (long)npm * nN * nks) return false;
        const int l = (int)L, ks = l / (npm * nN), t = l % (npm * nN);
        u.pn = t / npm; u.pm = pm0 + t % npm; u.ks = ks; u.ko = ks * kslice; u.nkt = kslice / BK; return true;
    }
    __device__ __forceinline__ void a_ready(const Unit&) const {}
    __device__ __forceinline__ void done(const Unit&) const {}
};
struct ComboOrder {
    StaticOrder s; SplitKOrder k; int rs;
    __host__ __device__ void init(const StaticOrder& s_, const SplitKOrder& k_) { s = s_; k = k_; rs = (s.nwg + s.G - 1) / s.G; }
    __host__ __device__ bool next(int i, Unit& u) const { if (i < rs) return s.next(i, u); return k.next(i - rs, u); }
    __device__ __forceinline__ void a_ready(const Unit&) const {}
    __device__ __forceinline__ void done(const Unit&) const {}
};
__device__ __forceinline__ unsigned cvt_pk_bf16(float lo, float hi) { unsigned r; asm volatile("v_cvt_pk_bf16_f32 %0, %1, %2" : "=v"(r) : "v"(lo), "v"(hi)); return r; }
__device__ __forceinline__ void st16_wt(void* p, u32x4 v) { asm volatile("global_store_dwordx4 %0, %1, off sc1\n\ts_nop 1" :: "v"(p), "v"(v) : "memory"); }
template <int ACT> struct EpiStore {
    static constexpr bool PERM = true, AFTER_DRAIN = false;
    bf16_t* O; int ldc; bf16_t* Os; size_t slab; int row_sub;
    __device__ __forceinline__ void operator()(const f32x4 (&acc)[2][2][4][2], const Unit& u, int wr, int wc, int fr, int fq) const {
        const int row0 = u.pm * BM + wr * 64 + fr - (u.ks < 0 ? 0 : row_sub); const int col0 = u.pn * BM + wc * 32 + 8 * fq; bf16_t* Ob = u.ks < 0 ? O : Os + (size_t)u.ks * slab;
#pragma unroll
        for (int ai = 0; ai < 2; ++ai)
#pragma unroll
            for (int m = 0; m < 4; ++m) { bf16_t* rowp = Ob + (size_t)(row0 + ai * HALF + m * 16) * ldc + col0;
#pragma unroll
                for (int bj = 0; bj < 2; ++bj) { f32x4 v0 = acc[ai][bj][m][0], v1 = acc[ai][bj][m][1];
                    if (ACT == 2) {
#pragma unroll
                        for (int e = 0; e < 4; ++e) { float a = v0[e] > 0.f ? v0[e] : 0.f; v0[e] = a * a; float b = v1[e] > 0.f ? v1[e] : 0.f; v1[e] = b * b; } }
                    u32x4 w; w.x = cvt_pk_bf16(v0[0], v0[1]); w.y = cvt_pk_bf16(v0[2], v0[3]); w.z = cvt_pk_bf16(v1[0], v1[1]); w.w = cvt_pk_bf16(v1[2], v1[3]);
                    st16_wt(rowp + bj * HALF, w); } }
    }
};
template <class Epi, class Sched, bool ALIGN_EPI = false, bool SP2 = false>
__device__ __forceinline__ void gemm_phase(PG8_LAS unsigned char* lds, const Gemm g, const Sched& S, const Epi& E) {
    const int tid = threadIdx.x, wid = __builtin_amdgcn_readfirstlane(tid >> 6), lane = tid & 63, wr = wid >> 2, wc = wid & 3, fr = lane & 15, fq = lane >> 4;
    const int K = g.ld;
    unsigned voffA[2], voffB[2];
#pragma unroll
    for (int i = 0; i < 2; ++i) { int R, C; stage_rc(tid * 16 + i * 8192, R, C); const int Rb = Epi::PERM ? ((R & ~31) + perm32(R & 31)) : R;
        voffA[i] = (unsigned)(R * K + C) * 2u; voffB[i] = (unsigned)(Rb * K + C) * 2u; }
    const size_t kstep = (size_t)(BK * 2);
    const size_t hstep = (size_t)HALF * K * 2;
    const size_t tstep = 2 * hstep;
    const unsigned ldsw = (unsigned)wid * 1024u;
    const int aoff = lds_byte(wr * 64 + fr, fq * 8), boff = lds_byte(wc * 32 + fr, fq * 8);
#define PG8_SA(b, h) (((b) * 2 + (h)) * HTB)
#define PG8_SB(b, h) ((4 + (b) * 2 + (h)) * HTB)
#define PG8_STAGE(bufoff, gbase, voff) do { _Pragma("unroll") for (int _i = 0; _i < 2; ++_i) \
        __builtin_amdgcn_global_load_lds((const unsigned*)((const char*)(gbase) + (voff)[_i]), (PG8_LAS unsigned*)(lds + (bufoff) + ldsw + _i * 8192), 16, 0, 0); } while (0)
#define PG8_LDA(dst, b, h) do { _Pragma("unroll") for (int m = 0; m < 4; ++m) _Pragma("unroll") for (int k = 0; k < 2; ++k) dst[m][k] = *(const PG8_LAS bf16x8*)(lds + PG8_SA(b, h) + aoff + m * 2048 + k * 1024); } while (0)
#define PG8_LDB(dst, b, h) do { _Pragma("unroll") for (int n = 0; n < 2; ++n) _Pragma("unroll") for (int k = 0; k < 2; ++k) dst[n][k] = *(const PG8_LAS bf16x8*)(lds + PG8_SB(b, h) + boff + n * 2048 + k * 1024); } while (0)
#define PG8_MMA(ai, bj, At, Bt) do { __builtin_amdgcn_s_setprio(1); _Pragma("unroll") for (int m = 0; m < 4; ++m) _Pragma("unroll") for (int n = 0; n < 2; ++n) _Pragma("unroll") for (int k = 0; k < 2; ++k) \
        acc[ai][bj][m][n] = __builtin_amdgcn_mfma_f32_16x16x32_bf16(Bt[n][k], At[m][k], acc[ai][bj][m][n], 0, 0, 0); __builtin_amdgcn_s_setprio(0); } while (0)
#define PG8_WAIT_V(n) asm volatile("s_waitcnt vmcnt(" #n ")" ::: "memory")
#define PG8_WAIT_L(n) asm volatile("s_waitcnt lgkmcnt(" #n ")" ::: "memory")
#define PG8_BAR __builtin_amdgcn_s_barrier()
#define PG8_SCHED __builtin_amdgcn_sched_barrier(0)
    Unit cur, nxt; int ui = 0;
    if (!S.next(0, cur)) return;
    f32x4 acc[2][2][4][2];
#pragma unroll
    for (int a = 0; a < 2; ++a)
#pragma unroll
        for (int b = 0; b < 2; ++b)
#pragma unroll
            for (int m = 0; m < 4; ++m)
#pragma unroll
                for (int n = 0; n < 2; ++n) acc[a][b][m][n] = (f32x4){0.f, 0.f, 0.f, 0.f};
    bf16x8 At[4][2], B0[2][2], B1[2][2];
    const char* cA = (const char*)g.A + (size_t)cur.pm * tstep + (size_t)cur.ko * 2; const char* cB = (const char*)g.Bt + (size_t)cur.pn * tstep + (size_t)cur.ko * 2;
    S.a_ready(cur);
    if constexpr (SP2) {
        PG8_STAGE(PG8_SB(0, 0), cB, voffB); PG8_STAGE(PG8_SB(0, 1), cB + hstep, voffB); PG8_STAGE(PG8_SA(0, 0), cA, voffA); PG8_STAGE(PG8_SA(0, 1), cA + hstep, voffA);
        if (wr == 1) PG8_BAR;
        PG8_WAIT_V(2); PG8_BAR;
        PG8_STAGE(PG8_SB(1, 0), cB + kstep, voffB); PG8_STAGE(PG8_SA(1, 0), cA + kstep, voffA); PG8_STAGE(PG8_SB(1, 1), cB + hstep + kstep, voffB);
        PG8_WAIT_V(6); PG8_BAR;
    } else {
        PG8_STAGE(PG8_SB(0, 0), cB, voffB); PG8_STAGE(PG8_SA(0, 0), cA, voffA); PG8_STAGE(PG8_SB(0, 1), cB + hstep, voffB); PG8_STAGE(PG8_SA(0, 1), cA + hstep, voffA);
        if (wr == 1) PG8_BAR;
        PG8_WAIT_V(4); PG8_BAR;
        PG8_STAGE(PG8_SB(1, 0), cB + kstep, voffB); PG8_STAGE(PG8_SA(1, 0), cA + kstep, voffA); PG8_STAGE(PG8_SB(1, 1), cB + hstep + kstep, voffB);
        PG8_WAIT_V(6); PG8_BAR;
    }
    for (;;) {
        const bool has_next = S.next(ui + 1, nxt); const int nt = cur.nkt;
        const char* nA = has_next ? (const char*)g.A + (size_t)nxt.pm * tstep + (size_t)nxt.ko * 2 : cA; const char* nB = has_next ? (const char*)g.Bt + (size_t)nxt.pn * tstep + (size_t)nxt.ko * 2 : cB;
        for (int t = 0; t < nt; t += 2) {
            const bool last = (t == nt - 2);
            const char* a1 = cA + (size_t)(t + 1) * kstep;
            const char* a2 = last ? nA : cA + (size_t)(t + 2) * kstep; const char* b2 = last ? nB : cB + (size_t)(t + 2) * kstep;
            const char* a3 = a2 + kstep; const char* b3 = b2 + kstep;
            if (last && has_next) S.a_ready(nxt);
            if constexpr (SP2) {
            PG8_LDB(B0, 0, 0); PG8_LDB(B1, 0, 1); PG8_SCHED; PG8_LDA(At, 0, 0); PG8_STAGE(PG8_SA(1, 1), a1 + hstep, voffA);
            PG8_WAIT_V(8); PG8_WAIT_L(0); PG8_BAR; PG8_MMA(0, 0, At, B0); PG8_MMA(0, 1, At, B1); PG8_BAR; PG8_SCHED;
            PG8_LDA(At, 0, 1); PG8_STAGE(PG8_SB(0, 0), b2, voffB); PG8_STAGE(PG8_SB(0, 1), b2 + hstep, voffB); PG8_STAGE(PG8_SA(0, 0), a2, voffA);
            PG8_WAIT_V(8); PG8_WAIT_L(0); PG8_BAR; PG8_MMA(1, 0, At, B0); PG8_MMA(1, 1, At, B1); PG8_BAR; PG8_SCHED;
            PG8_LDB(B0, 1, 0); PG8_LDB(B1, 1, 1); PG8_SCHED; PG8_LDA(At, 1, 0); PG8_STAGE(PG8_SA(0, 1), a2 + hstep, voffA);
            PG8_WAIT_V(8); PG8_WAIT_L(0); PG8_BAR; PG8_MMA(0, 0, At, B0); PG8_MMA(0, 1, At, B1); PG8_BAR; PG8_SCHED;
            PG8_LDA(At, 1, 1); PG8_STAGE(PG8_SB(1, 0), b3, voffB); PG8_STAGE(PG8_SB(1, 1), b3 + hstep, voffB); PG8_STAGE(PG8_SA(1, 0), a3, voffA);
            PG8_WAIT_V(8); PG8_WAIT_L(0); PG8_BAR; PG8_MMA(1, 0, At, B0); PG8_MMA(1, 1, At, B1); PG8_BAR; PG8_SCHED;
            } else {
            PG8_LDB(B0, 0, 0); PG8_SCHED; PG8_LDA(At, 0, 0); PG8_STAGE(PG8_SA(1, 1), a1 + hstep, voffA);
            PG8_WAIT_L(8); PG8_BAR; PG8_WAIT_L(0); PG8_MMA(0, 0, At, B0); PG8_BAR; PG8_SCHED;
            PG8_LDB(B1, 0, 1); PG8_STAGE(PG8_SB(0, 0), b2, voffB);
            PG8_BAR; PG8_WAIT_L(0); PG8_MMA(0, 1, At, B1); PG8_BAR;
            PG8_LDA(At, 0, 1); PG8_STAGE(PG8_SA(0, 0), a2, voffA);
            PG8_BAR; PG8_WAIT_L(0); PG8_MMA(1, 0, At, B0); PG8_BAR; PG8_SCHED;
            PG8_STAGE(PG8_SB(0, 1), b2 + hstep, voffB);
            PG8_WAIT_V(6); PG8_BAR; PG8_MMA(1, 1, At, B1); PG8_BAR;
            PG8_LDB(B0, 1, 0); PG8_SCHED; PG8_LDA(At, 1, 0); PG8_STAGE(PG8_SA(0, 1), a2 + hstep, voffA);
            PG8_WAIT_L(8); PG8_BAR; PG8_WAIT_L(0); PG8_MMA(0, 0, At, B0); PG8_BAR; PG8_SCHED;
            PG8_LDB(B1, 1, 1); PG8_STAGE(PG8_SB(1, 0), b3, voffB);
            PG8_BAR; PG8_WAIT_L(0); PG8_MMA(0, 1, At, B1); PG8_BAR;
            PG8_LDA(At, 1, 1); PG8_STAGE(PG8_SA(1, 0), a3, voffA);
            PG8_BAR; PG8_WAIT_L(0); PG8_MMA(1, 0, At, B0); PG8_BAR; PG8_SCHED;
            PG8_STAGE(PG8_SB(1, 1), b3 + hstep, voffB);
            PG8_WAIT_V(6); PG8_BAR; PG8_MMA(1, 1, At, B1); PG8_BAR;
            }
        }
        if constexpr (ALIGN_EPI) { if (wr == 0) PG8_BAR; }
        if constexpr (!Epi::AFTER_DRAIN) { E(acc, cur, wr, wc, fr, fq); S.done(cur); }
        if (!has_next) break;
#pragma unroll
        for (int a = 0; a < 2; ++a)
#pragma unroll
            for (int b = 0; b < 2; ++b)
#pragma unroll
                for (int m = 0; m < 4; ++m)
#pragma unroll
                    for (int n = 0; n < 2; ++n) acc[a][b][m][n] = (f32x4){0.f, 0.f, 0.f, 0.f};
        cur = nxt; cA = nA; cB = nB; ++ui;
        if constexpr (ALIGN_EPI) { if (wr == 1) PG8_BAR; }
    }
    PG8_WAIT_V(0);
    if constexpr (!ALIGN_EPI) { if (wr == 0) PG8_BAR; }
    PG8_BAR;
    if constexpr (Epi::AFTER_DRAIN) { E.fused(acc, cur, wr, wc, fr, fq, lds, wid, lane); S.done(cur); }
#undef PG8_SA
#undef PG8_SB
#undef PG8_STAGE
#undef PG8_LDA
#undef PG8_LDB
#undef PG8_MMA
#undef PG8_WAIT_V
#undef PG8_WAIT_L
#undef PG8_BAR
#undef PG8_SCHED
}
}
constexpr int NWAVES = 8;
#ifndef MK_PER_PHASE
#define MK_PER_PHASE 0
#endif
constexpr int N_PHASES = 20;

constexpr int NBATCH = 8, SEQ = 2048, LCTX = 256, DM = 1024, MLAT = NBATCH * SEQ, MCTX = NBATCH * LCTX, MALL = MLAT + MCTX;
constexpr int NPROJ = 3072, DIN = 2956, DFF = 4096;
constexpr int C_QA = 0, C_KA = 384, C_VA = 512, C_QR = 640, C_KR = 896, C_VR = 1152, C_GR = 1408, C_Z = 1664, C_XBC = 2048, C_DT = 2944;
constexpr int XBW = 896;
constexpr float EPS = 1e-6f;
constexpr float QSCALE = 0.125f * 1.4426950408889634f;
constexpr float LOG2E = 1.4426950408889634f;

constexpr size_t MiB = 1u << 20;
constexpr size_t WS_CTL = 0, CTL_ZERO_BYTES = 128 * 1024;
constexpr size_t WS_MOD = 1 * MiB;
constexpr size_t WS_WIN = 2 * MiB, WS_WOUT = 8 * MiB, WS_W1 = 10 * MiB, WS_W2 = 18 * MiB;
constexpr size_t WS_XN = 26 * MiB;
constexpr size_t WS_BIG = 62 * MiB;
constexpr size_t WS_XBC2 = 170 * MiB;
constexpr size_t WS_DTLA = 202 * MiB;
constexpr size_t WS_XC = 206 * MiB;
constexpr size_t WS_XB = 214 * MiB;
constexpr size_t WS_END = 256 * MiB;
static_assert(WS_BIG + (size_t)MALL * NPROJ * 2 <= WS_XBC2 && WS_XBC2 + (size_t)MALL * XBW * 2 <= WS_DTLA && WS_DTLA + (size_t)MALL * 24 * 4 <= WS_XC, "ws map 1");
static_assert(WS_BIG + (size_t)MALL * DFF * 2 <= WS_XC && WS_XB + (size_t)MLAT * DM * 2 <= WS_END && WS_XN + (size_t)MALL * DM * 2 <= WS_BIG, "ws map 2");
constexpr int CW_TMO = 0, CW_CODE = 1, CW_BAR = 4096, CW_QUEUE = 16384, CW_FLAGS = 20480;

constexpr int RING_OFF = 0, RING_BYTES = 131072;
constexpr int LDS_BYTES = 147456;
constexpr int LDSCTL_OFF = LDS_BYTES - 512, MISC_OFF = LDSCTL_OFF + 320;

#define GAS __attribute__((address_space(1)))
#define LAS __attribute__((address_space(3)))
typedef unsigned short bf16;
typedef unsigned v4u __attribute__((ext_vector_type(4)));
typedef unsigned v2u __attribute__((ext_vector_type(2)));
typedef float f32x4 __attribute__((ext_vector_type(4)));
typedef float f32x2 __attribute__((ext_vector_type(2)));
typedef float f32x16 __attribute__((ext_vector_type(16)));
typedef short bf16x8 __attribute__((ext_vector_type(8)));
typedef short s16x4 __attribute__((ext_vector_type(4)));
typedef __bf16 bf16x2_t __attribute__((ext_vector_type(2)));
typedef GAS unsigned gu32;
#define RLX_AGENT __ATOMIC_RELAXED, __HIP_MEMORY_SCOPE_AGENT
#define LDS_WAIT() asm volatile("s_waitcnt lgkmcnt(0)" ::: "memory")
#define VM_WAIT() asm volatile("s_waitcnt vmcnt(0)" ::: "memory")
__device__ __forceinline__ unsigned f2bf(float f) { unsigned u = __builtin_bit_cast(unsigned, f); return (u + 0x7fffu + ((u >> 16) & 1u)) >> 16; }
__device__ __forceinline__ unsigned pk2(float lo, float hi) { f32x2 v = {lo, hi}; bf16x2_t b = __builtin_convertvector(v, bf16x2_t); return __builtin_bit_cast(unsigned, b); }
__device__ __forceinline__ float bflo(unsigned u) { return __builtin_bit_cast(float, u << 16); }
__device__ __forceinline__ float bfhi(unsigned u) { return __builtin_bit_cast(float, u & 0xffff0000u); }
__device__ __forceinline__ float bf1(bf16 h) { return __builtin_bit_cast(float, (unsigned)h << 16); }
__device__ __forceinline__ float silu_f(float x) { return x / (1.f + expf(-x)); }
__device__ __forceinline__ float wave_sum(float v) {
#pragma unroll
    for (int o = 1; o < 64; o <<= 1) v += __shfl_xor(v, o);
    return v;
}
__device__ __forceinline__ float sum16(float v) {
    v += __shfl_xor(v, 1); v += __shfl_xor(v, 2); v += __shfl_xor(v, 4); v += __shfl_xor(v, 8); return v;
}
typedef short v4i16_t __attribute__((ext_vector_type(4)));
__device__ __forceinline__ s16x4 tr16(const LAS unsigned char* p) { return __builtin_bit_cast(s16x4, __builtin_amdgcn_ds_read_tr16_b64_v4i16((LAS v4i16_t*)p)); }
__device__ __forceinline__ float max3f(float a, float b, float c) { float r; asm("v_max3_f32 %0, %1, %2, %3" : "=v"(r) : "v"(a), "v"(b), "v"(c)); return r; }
#define CAT8(lo, hi) __builtin_shufflevector(lo, hi, 0, 1, 2, 3, 4, 5, 6, 7)
#define MFMA16(a, b, c) __builtin_amdgcn_mfma_f32_16x16x32_bf16((a), (b), (c), 0, 0, 0)
#define MFMA32(a, b, c) __builtin_amdgcn_mfma_f32_32x32x16_bf16((a), (b), (c), 0, 0, 0)

#define XB_TMO      128
#define XB_XCNT(j)  (256  + 64 * (j))
#define XB_XSUB(j)  (1280 + 64 * (j))
#define XB_XGEN(j)  (2304 + 64 * (j))
#define XB_TOP      3328
#define XB_TOPGEN   3392
#define XCD_BAR_WORDS 3456
#define XB_SPIN_CAP (1u << 18)

__device__ __forceinline__ unsigned xb_ld(unsigned* p)              { return __hip_atomic_load(p, __ATOMIC_RELAXED, __HIP_MEMORY_SCOPE_AGENT); }
__device__ __forceinline__ unsigned xb_add(unsigned* p, unsigned v) { return __hip_atomic_fetch_add(p, v, __ATOMIC_RELAXED, __HIP_MEMORY_SCOPE_AGENT); }
__device__ __forceinline__ unsigned xb_xcc_id() { return (unsigned)__builtin_amdgcn_s_getreg((3 << 11) | 20) & 0xFu; }
#define XB_SPIN(cond, bar) do { unsigned _sp = 0; while (cond) { __builtin_amdgcn_s_sleep(1); \
    if ((++_sp & 255u) == 0u) { if (xb_ld(&(bar)[XB_TMO])) break; if (_sp > XB_SPIN_CAP) { atomicAdd(&(bar)[XB_TMO], 1u); break; } } } } while (0)

struct XcdBarrier {
    unsigned* bar; unsigned x;
    volatile LAS unsigned* st;
};

__device__ __forceinline__ XcdBarrier xcd_barrier_post(unsigned* bar, volatile LAS unsigned* st) {
    XcdBarrier b; b.bar = bar; b.x = xb_xcc_id(); b.st = st;
    if (threadIdx.x == 0) (void)xb_add(&bar[XB_XCNT(b.x)], 1u);
    return b;
}
__device__ __forceinline__ void xcd_barrier_complete(unsigned* bar, unsigned x, unsigned& nloc, unsigned& nx) {
    const unsigned G = gridDim.x * gridDim.y * gridDim.z;
    unsigned sum, cnt, mine, sp = 0u;
    for (;;) {
        sum = 0u; cnt = 0u; mine = 0u;
#pragma unroll
        for (unsigned j = 0; j < 16; ++j) { const unsigned c = xb_ld(&bar[XB_XCNT(j)]); sum += c; cnt += (c > 0u) ? 1u : 0u; mine = (j == x) ? c : mine; }
        if (sum == G) break;
        __builtin_amdgcn_s_sleep(1);
        if ((++sp & 255u) == 0u) { if (xb_ld(&bar[XB_TMO])) break; if (sp > XB_SPIN_CAP) { atomicAdd(&bar[XB_TMO], 1u); break; } }
    }
    nloc = mine > 0u ? mine : 1u; nx = cnt > 0u ? cnt : 1u;
}

__device__ __forceinline__ void xcd_barrier(const XcdBarrier& b) {
    asm volatile("s_waitcnt vmcnt(0)" ::: "memory");
    __syncthreads();
    if (threadIdx.x == 0) {
        unsigned* bar = b.bar;
        __builtin_amdgcn_s_waitcnt(0);
        unsigned nloc = b.st[0], nx = b.st[1];
        if (nloc == 0u) { xcd_barrier_complete(bar, b.x, nloc, nx); b.st[0] = nloc; b.st[1] = nx; }
        const unsigned old = xb_add(&bar[XB_XSUB(b.x)], 1u);
        const unsigned gen = old / nloc;
        if (old + 1u == (gen + 1u) * nloc) {
            __builtin_amdgcn_fence(__ATOMIC_RELEASE, "agent");
            asm volatile("s_waitcnt vmcnt(0)" ::: "memory");
            const unsigned og = xb_add(&bar[XB_TOP], 1u);
            const unsigned tg = og / nx;
            if (og + 1u == (tg + 1u) * nx) xb_add(&bar[XB_TOPGEN], 1u);
            else XB_SPIN(xb_ld(&bar[XB_TOPGEN]) == tg, bar);
            __builtin_amdgcn_fence(__ATOMIC_ACQUIRE, "agent");
            xb_add(&bar[XB_XGEN(b.x)], 1u);
            asm volatile("s_waitcnt vmcnt(0)" ::: "memory");
        } else {
            XB_SPIN(xb_ld(&bar[XB_XGEN(b.x)]) == gen, bar);
            __builtin_amdgcn_fence(__ATOMIC_ACQUIRE, "agent");
            asm volatile("s_waitcnt vmcnt(0)" ::: "memory");
        }
    }
    __syncthreads();
}
struct Frame {
    LAS unsigned char* lds;
    volatile LAS unsigned* MISC;
    gu32* ctl;
    int tid, lane, wave;
    int vcu, G;
};
struct Args { const float* in[22]; float* out; unsigned char* ws; int ph_lo, ph_hi, li, pad; };

__host__ __device__ __forceinline__ int proj_natural(int pos) {
    if (pos >= 1152) return pos;
    if (pos >= 1024) return pos - 512;
    const int tile = pos >> 8, bj = (pos >> 7) & 1, wc = (pos >> 5) & 3, dim = 32 * bj + (pos & 31);
    const int base = tile == 0 ? wc * 64 : tile == 1 ? (wc < 2 ? (4 + wc) * 64 : C_KA + (wc - 2) * 64) : tile == 2 ? C_QR + wc * 64 : C_KR + wc * 64;
    return base + dim;
}
__device__ __forceinline__ void transpose_item(const float* W, int K, int Nreal, int nblk, bf16* WT, LAS float* scr, int item, int lane, bool permw = false) {
    const int kb = item / nblk, nb = item % nblk, k0 = 64 * kb, n0 = 32 * nb;
    const int nn = (permw ? proj_natural(n0) : n0) + (lane & 31); const bool okn = nn < Nreal; const int nnc = okn ? nn : Nreal - 1;
    float wv[32];
#pragma unroll
    for (int i = 0; i < 32; ++i) { const int kk = 2 * i + (lane >> 5); wv[i] = __builtin_nontemporal_load((const GAS float*)W + (size_t)(k0 + kk) * Nreal + nnc); }
#pragma unroll
    for (int i = 0; i < 32; ++i) { const int kk = 2 * i + (lane >> 5); scr[kk * 33 + (lane & 31)] = okn ? wv[i] : 0.f; }
    LDS_WAIT(); asm volatile("" ::: "memory");
    const int c = lane & 7;
#pragma unroll
    for (int j = 0; j < 4; ++j) { const int n = (lane >> 3) + 8 * j; const LAS float* s = scr + (8 * c) * 33 + n;
        v4u o; o.x = pk2(s[0 * 33], s[1 * 33]); o.y = pk2(s[2 * 33], s[3 * 33]); o.z = pk2(s[4 * 33], s[5 * 33]); o.w = pk2(s[6 * 33], s[7 * 33]);
        *(GAS v4u*)(WT + (size_t)(n0 + n) * K + k0 + 8 * c) = o; }
    LDS_WAIT(); asm volatile("" ::: "memory");
}
__device__ __forceinline__ void convert_weights(Frame& F, const Args& A, int layer, int part) {
    LAS float* scr = (LAS float*)(F.lds + RING_OFF + F.wave * 16384);
    const int gw = F.vcu * NWAVES + F.wave, NGW = F.G * NWAVES;
    const float* Win = A.in[7] + (size_t)layer * DM * DIN; const float* Wout = A.in[8] + (size_t)layer * DM * DM;
    const float* W1 = A.in[20] + (size_t)layer * DM * DFF; const float* W2 = A.in[21] + (size_t)layer * DFF * DM;
    bf16* Win_t = (bf16*)(A.ws + WS_WIN); bf16* Wout_t = (bf16*)(A.ws + WS_WOUT); bf16* W1_t = (bf16*)(A.ws + WS_W1); bf16* W2_t = (bf16*)(A.ws + WS_W2);
    constexpr int I_IN = (DM / 64) * (NPROJ / 32), I_OUT = (DM / 64) * (DM / 32), I_1 = (DM / 64) * (DFF / 32), I_2 = (DFF / 64) * (DM / 32);
    if (part == 0) { for (int it = gw; it < I_IN; it += NGW) transpose_item(Win, DM, DIN, NPROJ / 32, Win_t, scr, it, F.lane, true); return; }
    if (part == 2) {
        const int h0 = (MALL / 256) * (DFF / 256) - 4 * F.G; const int w0 = (h0 > 0 && h0 < F.G) ? h0 : 0; if ((int)blockIdx.x < w0) return;
        for (int it = ((int)blockIdx.x - w0) * NWAVES + F.wave; it < I_IN; it += (F.G - w0) * NWAVES) transpose_item(Win, DM, DIN, NPROJ / 32, Win_t, scr, it, F.lane, true);
        return; }
    const int idle0 = (MALL / 256) * (NPROJ / 256) - 3 * F.G;
    const int w0 = (idle0 > 0 && idle0 < F.G) ? idle0 : 0; if ((int)blockIdx.x < w0) return;
    for (int it = ((int)blockIdx.x - w0) * NWAVES + F.wave; it < I_OUT + I_1 + I_2; it += (F.G - w0) * NWAVES) {
        int r = it;
        if (r < I_OUT) { transpose_item(Wout, DM, DM, DM / 32, Wout_t, scr, r, F.lane); continue; } r -= I_OUT;
        if (r < I_1) { transpose_item(W1, DM, DFF, DFF / 32, W1_t, scr, r, F.lane); continue; } r -= I_1;
        transpose_item(W2, DFF, DM, DM / 32, W2_t, scr, r, F.lane);
    }
}
__device__ __forceinline__ void mod_phase(Frame& F, const Args& A) {
    LAS float* sact = (LAS float*)(F.lds + RING_OFF);
    LAS float* red = (LAS float*)(F.lds + RING_OFF + 36864);
    float* MOD = (float*)(A.ws + WS_MOD);
    bool have = false;
    for (int unit = F.vcu; unit < 2 * 96; unit += F.G) {
        if (!have) {
            for (int i = F.tid; i < 9 * 1024; i += NWAVES * 64) { const int r = i >> 10, k = i & 1023; const float v = r < 8 ? A.in[1][r * DM + k] : A.in[3][k]; sact[i] = silu_f(v); }
            __syncthreads(); have = true;
        }
        const int layer = unit / 96, cb = unit % 96;
        const float* W = A.in[4] + (size_t)layer * DM * 6144 + cb * 64 + F.lane;
        float acc[9];
#pragma unroll
        for (int r = 0; r < 9; ++r) acc[r] = 0.f;
        for (int kk0 = 0; kk0 < 128; kk0 += 32) { float wv[32];
#pragma unroll
            for (int j = 0; j < 32; ++j) wv[j] = __builtin_nontemporal_load((const GAS float*)W + (size_t)(F.wave * 128 + kk0 + j) * 6144);
#pragma unroll
            for (int j = 0; j < 32; ++j) { const int k = F.wave * 128 + kk0 + j;
#pragma unroll
                for (int r = 0; r < 9; ++r) acc[r] += sact[r * 1024 + k] * wv[j]; } }
#pragma unroll
        for (int r = 0; r < 9; ++r) red[(F.wave * 9 + r) * 64 + F.lane] = acc[r];
        __syncthreads();
        for (int i = F.tid; i < 576; i += NWAVES * 64) { const int r = i >> 6, l = i & 63; float s = 0.f;
#pragma unroll
            for (int w = 0; w < 8; ++w) s += red[(w * 9 + r) * 64 + l];
            MOD[(size_t)(layer * 9 + r) * 6144 + cb * 64 + l] = s + A.in[5][layer * 6144 + cb * 64 + l]; }
        __syncthreads();
    }
    __syncthreads();
}

struct RowPass {
    const void* xs_lat; const float* xs_ctx; const bf16* o; void* xd_lat; float* xd_ctx; bf16* xn;
    const float* gate; const float* ngo; const float* ngx; const float* scale; const float* shift; int M; const bf16* oslab;
};
__device__ __forceinline__ f32x4 bf4(v2u w) { return (f32x4){bflo(w.x), bfhi(w.x), bflo(w.y), bfhi(w.y)}; }
template <int NR, int XS, int XD>
__device__ __forceinline__ void row_pass_rows(const RowPass& P, const int (&mr)[NR], int lane) {
    f32x4 v[NR][4], ov[NR][4]; int mrow[NR]; bool lat[NR];
#pragma unroll
    for (int q = 0; q < NR; ++q) { const int m = mr[q]; lat[q] = m < MLAT; mrow[q] = lat[q] ? (m >> 11) : 8;
        if (XS == 1 && lat[q]) { const v2u* xr = (const v2u*)((const bf16*)P.xs_lat + (size_t)m * DM);
#pragma unroll
            for (int j = 0; j < 4; ++j) v[q][j] = bf4(__builtin_nontemporal_load(xr + lane + 64 * j));
        } else { const float* xr = lat[q] ? (const float*)P.xs_lat + (size_t)m * DM : P.xs_ctx + (size_t)(m - MLAT) * DM;
#pragma unroll
            for (int j = 0; j < 4; ++j) v[q][j] = __builtin_nontemporal_load((const f32x4*)xr + lane + 64 * j); } }
    if (P.o) {
#pragma unroll
        for (int q = 0; q < NR; ++q) { const int m = mr[q];
            if (!lat[q] && P.oslab) {
#pragma unroll
                for (int j = 0; j < 4; ++j) ov[q][j] = (f32x4){0.f, 0.f, 0.f, 0.f};
                v2u sw[8][4];
#pragma unroll
                for (int ks = 0; ks < 8; ++ks) { const v2u* orow = (const v2u*)(P.oslab + ((size_t)ks * MCTX + (m - MLAT)) * DM);
#pragma unroll
                    for (int j = 0; j < 4; ++j) sw[ks][j] = __builtin_nontemporal_load(orow + lane + 64 * j); }
#pragma unroll
                for (int ks = 0; ks < 8; ++ks)
#pragma unroll
                    for (int j = 0; j < 4; ++j) ov[q][j] = ov[q][j] + bf4(sw[ks][j]);
            } else { const v2u* orow = (const v2u*)(P.o + (size_t)m * DM);
#pragma unroll
                for (int j = 0; j < 4; ++j) { const v2u w = __builtin_nontemporal_load(orow + lane + 64 * j); ov[q][j] = bf4(w); } } }
        float ss[NR];
#pragma unroll
        for (int q = 0; q < NR; ++q) { ss[q] = 0.f;
#pragma unroll
            for (int j = 0; j < 4; ++j) ss[q] += (ov[q][j].x * ov[q][j].x + ov[q][j].y * ov[q][j].y) + (ov[q][j].z * ov[q][j].z + ov[q][j].w * ov[q][j].w); }
#pragma unroll
        for (int o = 1; o < 64; o <<= 1) {
#pragma unroll
            for (int q = 0; q < NR; ++q) ss[q] += __shfl_xor(ss[q], o); }
#pragma unroll
        for (int q = 0; q < NR; ++q) { const float rstd = rsqrtf(ss[q] * (1.f / DM) + EPS);
#pragma unroll
            for (int j = 0; j < 4; ++j) { const f32x4 g4 = ((const f32x4*)(P.gate + (size_t)mrow[q] * 6144))[lane + 64 * j]; const f32x4 n4 = ((const f32x4*)P.ngo)[lane + 64 * j];
                v[q][j] = v[q][j] + g4 * ((ov[q][j] * rstd) * n4); } }
    }
#pragma unroll
    for (int q = 0; q < NR; ++q) { const int m = mr[q];
        if (lat[q]) {
            if (P.xd_lat) {
                if (XD == 1) { v2u* xd = (v2u*)((bf16*)P.xd_lat + (size_t)m * DM);
#pragma unroll
                    for (int j = 0; j < 4; ++j) { v2u w; w.x = pk2(v[q][j].x, v[q][j].y); w.y = pk2(v[q][j].z, v[q][j].w); __builtin_nontemporal_store(w, xd + lane + 64 * j); }
                } else { float* xd = (float*)P.xd_lat + (size_t)m * DM;
#pragma unroll
                    for (int j = 0; j < 4; ++j) __builtin_nontemporal_store(v[q][j], (f32x4*)xd + lane + 64 * j); } }
        } else if (P.xd_ctx) { float* xd = P.xd_ctx + (size_t)(m - MLAT) * DM;
#pragma unroll
            for (int j = 0; j < 4; ++j) __builtin_nontemporal_store(v[q][j], (f32x4*)xd + lane + 64 * j); } }
    if (P.xn) {
        float ss[NR];
#pragma unroll
        for (int q = 0; q < NR; ++q) { ss[q] = 0.f;
#pragma unroll
            for (int j = 0; j < 4; ++j) ss[q] += (v[q][j].x * v[q][j].x + v[q][j].y * v[q][j].y) + (v[q][j].z * v[q][j].z + v[q][j].w * v[q][j].w); }
#pragma unroll
        for (int o = 1; o < 64; o <<= 1) {
#pragma unroll
            for (int q = 0; q < NR; ++q) ss[q] += __shfl_xor(ss[q], o); }
#pragma unroll
        for (int q = 0; q < NR; ++q) { const float rstd = rsqrtf(ss[q] * (1.f / DM) + EPS); v2u* xo = (v2u*)(P.xn + (size_t)mr[q] * DM);
#pragma unroll
            for (int j = 0; j < 4; ++j) { const f32x4 n4 = ((const f32x4*)P.ngx)[lane + 64 * j]; const f32x4 sc = ((const f32x4*)(P.scale + (size_t)mrow[q] * 6144))[lane + 64 * j];
                const f32x4 sh = ((const f32x4*)(P.shift + (size_t)mrow[q] * 6144))[lane + 64 * j];
                const f32x4 y = ((v[q][j] * rstd) * n4) * (sc + 1.f) + sh; v2u w; w.x = pk2(y.x, y.y); w.y = pk2(y.z, y.w); xo[lane + 64 * j] = w; } }
    }
}
template <int XS> struct RowRaw;
template <> struct RowRaw<0> { f32x4 x[2][4]; v2u o[2][4]; };
template <> struct RowRaw<1> { v2u x[2][4]; v2u o[2][4]; };
template <int XS>
__device__ __forceinline__ void row_raw_load(const RowPass& P, RowRaw<XS>& R, int m0, int m1, int lane) {
    const int mr[2] = {m0, m1};
#pragma unroll
    for (int q = 0; q < 2; ++q) {
        if constexpr (XS == 1) { const v2u* xr = (const v2u*)((const bf16*)P.xs_lat + (size_t)mr[q] * DM);
#pragma unroll
            for (int j = 0; j < 4; ++j) R.x[q][j] = __builtin_nontemporal_load(xr + lane + 64 * j);
        } else { const float* xr = (const float*)P.xs_lat + (size_t)mr[q] * DM;
#pragma unroll
            for (int j = 0; j < 4; ++j) R.x[q][j] = __builtin_nontemporal_load((const f32x4*)xr + lane + 64 * j); }
        if (P.o) { const v2u* orow = (const v2u*)(P.o + (size_t)mr[q] * DM);
#pragma unroll
            for (int j = 0; j < 4; ++j) R.o[q][j] = __builtin_nontemporal_load(orow + lane + 64 * j); } }
}
template <int XS, int XD>
__device__ __forceinline__ void row_raw_compute(const RowPass& P, const RowRaw<XS>& R, int m0, int m1, int lane) {
    const int mr[2] = {m0, m1}; f32x4 v[2][4];
#pragma unroll
    for (int q = 0; q < 2; ++q)
#pragma unroll
        for (int j = 0; j < 4; ++j) { if constexpr (XS == 1) v[q][j] = bf4(R.x[q][j]); else v[q][j] = R.x[q][j]; }
    if (P.o) {
        f32x4 ov[2][4]; float ss[2];
#pragma unroll
        for (int q = 0; q < 2; ++q) { ss[q] = 0.f;
#pragma unroll
            for (int j = 0; j < 4; ++j) { ov[q][j] = bf4(R.o[q][j]);
                ss[q] += (ov[q][j].x * ov[q][j].x + ov[q][j].y * ov[q][j].y) + (ov[q][j].z * ov[q][j].z + ov[q][j].w * ov[q][j].w); } }
#pragma unroll
        for (int o = 1; o < 64; o <<= 1) { ss[0] += __shfl_xor(ss[0], o); ss[1] += __shfl_xor(ss[1], o); }
#pragma unroll
        for (int q = 0; q < 2; ++q) { const float rstd = rsqrtf(ss[q] * (1.f / DM) + EPS); const int mrow = mr[q] >> 11;
#pragma unroll
            for (int j = 0; j < 4; ++j) { const f32x4 g4 = ((const f32x4*)(P.gate + (size_t)mrow * 6144))[lane + 64 * j]; const f32x4 n4 = ((const f32x4*)P.ngo)[lane + 64 * j];
                v[q][j] = v[q][j] + g4 * ((ov[q][j] * rstd) * n4); } }
    }
    if (P.xd_lat) {
#pragma unroll
        for (int q = 0; q < 2; ++q)
#pragma unroll
            for (int j = 0; j < 4; ++j) {
                if constexpr (XD == 1) { v2u w; w.x = pk2(v[q][j].x, v[q][j].y); w.y = pk2(v[q][j].z, v[q][j].w); __builtin_nontemporal_store(w, (v2u*)((bf16*)P.xd_lat + (size_t)mr[q] * DM) + lane + 64 * j); }
                else __builtin_nontemporal_store(v[q][j], (f32x4*)((float*)P.xd_lat + (size_t)mr[q] * DM) + lane + 64 * j); } }
    if (P.xn) {
        float ss[2];
#pragma unroll
        for (int q = 0; q < 2; ++q) { ss[q] = 0.f;
#pragma unroll
            for (int j = 0; j < 4; ++j) ss[q] += (v[q][j].x * v[q][j].x + v[q][j].y * v[q][j].y) + (v[q][j].z * v[q][j].z + v[q][j].w * v[q][j].w); }
#pragma unroll
        for (int o = 1; o < 64; o <<= 1) { ss[0] += __shfl_xor(ss[0], o); ss[1] += __shfl_xor(ss[1], o); }
#pragma unroll
        for (int q = 0; q < 2; ++q) { const float rstd = rsqrtf(ss[q] * (1.f / DM) + EPS); const int mrow = mr[q] >> 11; v2u* xo = (v2u*)(P.xn + (size_t)mr[q] * DM);
#pragma unroll
            for (int j = 0; j < 4; ++j) { const f32x4 n4 = ((const f32x4*)P.ngx)[lane + 64 * j]; const f32x4 sc = ((const f32x4*)(P.scale + (size_t)mrow * 6144))[lane + 64 * j];
                const f32x4 sh = ((const f32x4*)(P.shift + (size_t)mrow * 6144))[lane + 64 * j];
                const f32x4 y = ((v[q][j] * rstd) * n4) * (sc + 1.f) + sh; v2u w; w.x = pk2(y.x, y.y); w.y = pk2(y.z, y.w); xo[lane + 64 * j] = w; } }
    }
}
template <int XS, int XD>
__device__ __forceinline__ void row_raw_compute1(const RowPass& P, const RowRaw<XS>& R, const int q, int m, int lane) {
    f32x4 v[4];
#pragma unroll
    for (int j = 0; j < 4; ++j) { if constexpr (XS == 1) v[j] = bf4(R.x[q][j]); else v[j] = R.x[q][j]; }
    const int mrow = m >> 11;
    if (P.o) {
        f32x4 ov[4]; float ss = 0.f;
#pragma unroll
        for (int j = 0; j < 4; ++j) { ov[j] = bf4(R.o[q][j]); ss += (ov[j].x * ov[j].x + ov[j].y * ov[j].y) + (ov[j].z * ov[j].z + ov[j].w * ov[j].w); }
#pragma unroll
        for (int o = 1; o < 64; o <<= 1) ss += __shfl_xor(ss, o);
        const float rstd = rsqrtf(ss * (1.f / DM) + EPS);
#pragma unroll
        for (int j = 0; j < 4; ++j) { const f32x4 g4 = ((const f32x4*)(P.gate + (size_t)mrow * 6144))[lane + 64 * j]; const f32x4 n4 = ((const f32x4*)P.ngo)[lane + 64 * j];
            v[j] = v[j] + g4 * ((ov[j] * rstd) * n4); }
    }
    if (P.xd_lat) {
#pragma unroll
        for (int j = 0; j < 4; ++j) {
            if constexpr (XD == 1) { v2u w; w.x = pk2(v[j].x, v[j].y); w.y = pk2(v[j].z, v[j].w); __builtin_nontemporal_store(w, (v2u*)((bf16*)P.xd_lat + (size_t)m * DM) + lane + 64 * j); }
            else __builtin_nontemporal_store(v[j], (f32x4*)((float*)P.xd_lat + (size_t)m * DM) + lane + 64 * j); } }
    if (P.xn) {
        float ss = 0.f;
#pragma unroll
        for (int j = 0; j < 4; ++j) ss += (v[j].x * v[j].x + v[j].y * v[j].y) + (v[j].z * v[j].z + v[j].w * v[j].w);
#pragma unroll
        for (int o = 1; o < 64; o <<= 1) ss += __shfl_xor(ss, o);
        const float rstd = rsqrtf(ss * (1.f / DM) + EPS); v2u* xo = (v2u*)(P.xn + (size_t)m * DM);
#pragma unroll
        for (int j = 0; j < 4; ++j) { const f32x4 n4 = ((const f32x4*)P.ngx)[lane + 64 * j]; const f32x4 sc = ((const f32x4*)(P.scale + (size_t)mrow * 6144))[lane + 64 * j];
            const f32x4 sh = ((const f32x4*)(P.shift + (size_t)mrow * 6144))[lane + 64 * j];
            const f32x4 y = ((v[j] * rstd) * n4) * (sc + 1.f) + sh; v2u w; w.x = pk2(y.x, y.y); w.y = pk2(y.z, y.w); xo[lane + 64 * j] = w; }
    }
}
template <int XS, int XD, bool QUAD = (XS == 1)>
__device__ __forceinline__ void row_pass(Frame& F, const RowPass& P) {
    const int gw = F.vcu * NWAVES + F.wave, NGW = F.G * NWAVES, lane = F.lane;
    const int Ml = P.M < MLAT ? P.M : MLAT;
    int m = gw;
    if constexpr (QUAD) {
        if (m + 3 * NGW < Ml) {
            RowRaw<XS> c0, c1; row_raw_load<XS>(P, c0, m, m + NGW, lane); row_raw_load<XS>(P, c1, m + 2 * NGW, m + 3 * NGW, lane);
            for (;;) {
                const int mn = m + 4 * NGW; const bool more = mn + 3 * NGW < Ml;
                RowRaw<XS> n0, n1;
                if (more) { row_raw_load<XS>(P, n0, mn, mn + NGW, lane); row_raw_load<XS>(P, n1, mn + 2 * NGW, mn + 3 * NGW, lane); }
                row_raw_compute1<XS, XD>(P, c0, 0, m, lane); row_raw_compute1<XS, XD>(P, c0, 1, m + NGW, lane);
                row_raw_compute1<XS, XD>(P, c1, 0, m + 2 * NGW, lane); row_raw_compute1<XS, XD>(P, c1, 1, m + 3 * NGW, lane);
                m = mn;
                if (!more) break;
                c0 = n0; c1 = n1;
            }
        }
    }
    if (m + NGW < Ml) {
        RowRaw<XS> cur; row_raw_load<XS>(P, cur, m, m + NGW, lane);
        for (;;) {
            const int mn = m + 2 * NGW; const bool more = mn + NGW < Ml;
            RowRaw<XS> nxt;
            if (more) row_raw_load<XS>(P, nxt, mn, mn + NGW, lane);
            row_raw_compute<XS, XD>(P, cur, m, m + NGW, lane);
            m = mn;
            if (!more) break;
            cur = nxt;
        }
    }
    for (; m < P.M; m += NGW) { const int mr[1] = {m}; row_pass_rows<1, XS, XD>(P, mr, lane); }
}

constexpr int ROPE_LDS_OFF = 131072;
__device__ __forceinline__ void fill_rope_table(Frame& F) {
    LAS float* tab = (LAS float*)(F.lds + ROPE_LDS_OFF);
    for (int i = F.tid; i < 1024; i += NWAVES * 64) { const int pos = i >> 4, j = i & 15; const float rev = (float)pos * exp2f(-(float)j * 0.83048202372184058696f) * 0.15915494309189533577f; const float fr = rev - floorf(rev);
        tab[2 * i] = __builtin_amdgcn_cosf(fr); tab[2 * i + 1] = __builtin_amdgcn_sinf(fr); }
    __syncthreads();
}
struct EpiProj {
    static constexpr bool PERM = true, AFTER_DRAIN = false;
    bf16* O; const float* qn; const float* kn; const LAS float* rope;
    __device__ __forceinline__ void operator()(const pg8::f32x4 (&acc)[2][2][4][2], const pg8::Unit& u, int wr, int wc, int fr, int fq) const {
        const int row0 = u.pm * 256 + wr * 64 + fr;
        if (u.pn >= 4) {
#pragma unroll
            for (int ai = 0; ai < 2; ++ai)
#pragma unroll
                for (int m = 0; m < 4; ++m) { bf16* rowp = O + (size_t)(row0 + ai * 128 + m * 16) * NPROJ;
#pragma unroll
                    for (int bj = 0; bj < 2; ++bj) { const int pos = u.pn * 256 + bj * 128 + wc * 32 + 8 * fq; const int col = pos < 1152 ? pos - 512 : pos;
                        const pg8::f32x4 v0 = acc[ai][bj][m][0], v1 = acc[ai][bj][m][1];
                        v4u w; w.x = pk2(v0[0], v0[1]); w.y = pk2(v0[2], v0[3]); w.z = pk2(v1[0], v1[1]); w.w = pk2(v1[2], v1[3]);
                        *(v4u*)(rowp + col) = w; } }
            return;
        }
        const int pn = u.pn; const bool att = pn < 2, iskatt = (pn == 1) && (wc >= 2), lat = u.pm < MLAT / 256;
        const int hb = pn == 0 ? wc * 64 : pn == 1 ? (wc < 2 ? (4 + wc) * 64 : C_KA + (wc - 2) * 64) : pn == 2 ? C_QR + wc * 64 : C_KR + wc * 64;
        const float scl = att ? (iskatt ? 1.f : QSCALE) : (pn == 3 ? 0.125f : 1.f);
        float gn[2][8];
        { const float* gp = iskatt ? kn : qn;
#pragma unroll
          for (int bj = 0; bj < 2; ++bj) { const f32x4 a = *(const f32x4*)(gp + 32 * bj + 8 * fq), b = *(const f32x4*)(gp + 32 * bj + 8 * fq + 4);
              gn[bj][0] = a.x; gn[bj][1] = a.y; gn[bj][2] = a.z; gn[bj][3] = a.w; gn[bj][4] = b.x; gn[bj][5] = b.y; gn[bj][6] = b.z; gn[bj][7] = b.w; } }
        const bool up = (fq >> 1) & 1; const int jb = 8 * (fq & 1);
#pragma unroll
        for (int ai = 0; ai < 2; ++ai)
#pragma unroll
            for (int m = 0; m < 4; ++m) {
                const int r = row0 + ai * 128 + m * 16; float x[2][8];
#pragma unroll
                for (int bj = 0; bj < 2; ++bj)
#pragma unroll
                    for (int e = 0; e < 8; ++e) x[bj][e] = acc[ai][bj][m][e >> 2][e & 3];
                if (att) { float ss = 0.f;
#pragma unroll
                    for (int bj = 0; bj < 2; ++bj)
#pragma unroll
                        for (int e = 0; e < 8; ++e) ss += x[bj][e] * x[bj][e];
                    ss += __shfl_xor(ss, 16); ss += __shfl_xor(ss, 32);
                    const float rstd = rsqrtf(ss * (1.f / 64.f) + EPS);
#pragma unroll
                    for (int bj = 0; bj < 2; ++bj)
#pragma unroll
                        for (int e = 0; e < 8; ++e) x[bj][e] = (x[bj][e] * rstd) * gn[bj][e]; }
                if (lat) { const int t = r & (SEQ - 1);
#pragma unroll
                    for (int bj = 0; bj < 2; ++bj) { const int pos = bj ? (t & 63) : (t >> 6); const LAS f32x4* tp = (const LAS f32x4*)(rope + (pos * 16 + jb) * 2);
                        const f32x4 t0 = tp[0], t1 = tp[1], t2 = tp[2], t3 = tp[3];
                        const float cs[8] = {t0.x, t0.z, t1.x, t1.z, t2.x, t2.z, t3.x, t3.z}, sn[8] = {t0.y, t0.w, t1.y, t1.w, t2.y, t2.w, t3.y, t3.w};
#pragma unroll
                        for (int e = 0; e < 8; ++e) { const float pr = __shfl_xor(x[bj][e], 32); x[bj][e] = up ? (x[bj][e] * cs[e] + pr * sn[e]) : (x[bj][e] * cs[e] - pr * sn[e]); } } }
                bf16* rowp = O + (size_t)r * NPROJ + hb + 8 * fq;
#pragma unroll
                for (int bj = 0; bj < 2; ++bj) { v4u w; w.x = pk2(x[bj][0] * scl, x[bj][1] * scl); w.y = pk2(x[bj][2] * scl, x[bj][3] * scl); w.z = pk2(x[bj][4] * scl, x[bj][5] * scl); w.w = pk2(x[bj][6] * scl, x[bj][7] * scl);
                    *(v4u*)(rowp + 32 * bj) = w; }
            }
    }
};
__device__ __forceinline__ void prep_rows(const Args& A, unsigned char* ws, int layer, int rowbase, int nrows, int gt, int NGT) {
    bf16* PROJ = (bf16*)(ws + WS_BIG); bf16* XBC2 = (bf16*)(ws + WS_XBC2); float* DTLA = (float*)(ws + WS_DTLA);
    {
        const float* cw = A.in[14] + (size_t)layer * 5 * XBW; const float* cb = A.in[15] + (size_t)layer * XBW;
        constexpr int NCH = XBW / 8; const int NIT = (nrows / 16) * NCH;
        for (int it = gt; it < NIT; it += NGT) {
            const int run = it / NCH, ch = it % NCH, c0 = ch * 8, row0 = rowbase + run * 16;
            const int sbeg = row0 < MLAT ? (row0 & ~(SEQ - 1)) : MLAT + ((row0 - MLAT) & ~(LCTX - 1));
            const int send = sbeg + (row0 < MLAT ? SEQ : LCTX);
            float w[5][8], bias[8];
#pragma unroll
            for (int t = 0; t < 5; ++t) { const f32x4 a = *(const f32x4*)(cw + t * XBW + c0), b = *(const f32x4*)(cw + t * XBW + c0 + 4);
                w[t][0] = a.x; w[t][1] = a.y; w[t][2] = a.z; w[t][3] = a.w; w[t][4] = b.x; w[t][5] = b.y; w[t][6] = b.z; w[t][7] = b.w; }
            { const f32x4 a = *(const f32x4*)(cb + c0), b = *(const f32x4*)(cb + c0 + 4); bias[0] = a.x; bias[1] = a.y; bias[2] = a.z; bias[3] = a.w; bias[4] = b.x; bias[5] = b.y; bias[6] = b.z; bias[7] = b.w; }
            v4u rows[20];
#pragma unroll
            for (int t = 0; t < 20; ++t) { const int r = row0 - 2 + t; const bool in = (r >= sbeg && r < send); const int rc = in ? r : row0; const unsigned mk = in ? 0xffffffffu : 0u;
                v4u v = __builtin_nontemporal_load((const v4u*)(PROJ + (size_t)rc * NPROJ + C_XBC + c0)); v.x &= mk; v.y &= mk; v.z &= mk; v.w &= mk; rows[t] = v; }
#pragma unroll
            for (int rr = 0; rr < 16; ++rr) {
                float acc[8];
#pragma unroll
                for (int e = 0; e < 8; ++e) acc[e] = bias[e];
#pragma unroll
                for (int t = 0; t < 5; ++t) {
#pragma unroll
                    for (int e2 = 0; e2 < 4; ++e2) { const unsigned u = rows[rr + t][e2]; acc[2 * e2] += w[t][2 * e2] * bflo(u); acc[2 * e2 + 1] += w[t][2 * e2 + 1] * bfhi(u); } }
                v4u o;
#pragma unroll
                for (int e2 = 0; e2 < 4; ++e2) o[e2] = pk2(acc[2 * e2] * __builtin_amdgcn_rcpf(1.f + __expf(-acc[2 * e2])), acc[2 * e2 + 1] * __builtin_amdgcn_rcpf(1.f + __expf(-acc[2 * e2 + 1])));
                *(v4u*)(XBC2 + (size_t)(row0 + rr) * XBW + c0) = o;
            }
        }
    }
    {
        const float* dtb = A.in[16] + layer * 12; const float* alog = A.in[17] + layer * 12;
        for (int it = gt; it < nrows * 12; it += NGT) {
            const int row = rowbase + it / 12, j = it % 12;
            const float xv = bf1(PROJ[(size_t)row * NPROJ + C_DT + j]) + dtb[j];
            const float dt = xv > 20.f ? xv : log1pf(expf(xv));
            DTLA[(size_t)row * 24 + j] = dt; DTLA[(size_t)row * 24 + 12 + j] = -dt * expf(alog[j]);
        }
    }
}
constexpr int AT_KSTR = 144, AT_VSTR = 192, AT_TK = 128, AT_KBYTES = AT_TK * AT_KSTR, AT_VBYTES = AT_TK * AT_VSTR;
constexpr float AT_THR = 6.0f;
__device__ __forceinline__ void attn_unit(LAS unsigned char* lds, const bf16* PROJ, bf16* MIXA, const float* qn, const float* kn, int b, int hq, int qrow0, int kt0, int nkt, int tid, int lane, int wave) {
    const int g = hq / 3, r32 = lane & 31, hi = lane >> 5;
    const GAS bf16* PROJg = (const GAS bf16*)PROJ; GAS bf16* MIXAg = (GAS bf16*)MIXA;
    LAS unsigned char* QP = lds + 2 * AT_KBYTES + 2 * AT_VBYTES + wave * 4096 + lane * 16;
    bf16x8 qf_in[4];
    { const GAS bf16* qp = PROJg + (size_t)(qrow0 + wave * 32 + r32) * NPROJ + C_QA + hq * 64 + hi * 8;
#pragma unroll
      for (int d0 = 0; d0 < 4; ++d0) qf_in[d0] = *(const GAS bf16x8*)(qp + d0 * 16); }
    const int lkey = tid >> 3, lch = tid & 7;
    const GAS bf16* kcol = PROJg + C_KA + g * 64 + lch * 8; const GAS bf16* vcol = PROJg + C_VA + g * 64 + lch * 8;
    LAS unsigned char* KB = lds; LAS unsigned char* VB = lds + 2 * AT_KBYTES;
    const int kwoff = lkey * AT_KSTR + lch * 16, vwoff = lkey * AT_VSTR + lch * 16;
    const int kroff = r32 * AT_KSTR + hi * 16;
    const int vroff = (4 * hi + ((lane & 15) >> 2)) * AT_VSTR + (((lane >> 4) & 1) * 16 + (lane & 3) * 4) * 2;
    float m = 0.f, lsum = 0.f; f32x16 o0, o1, negm, zero16;
#pragma unroll
    for (int r = 0; r < 16; ++r) { o0[r] = 0.f; o1[r] = 0.f; negm[r] = 0.f; zero16[r] = 0.f; }
    v4u kreg[2], vreg[2];
#define AT_LOAD(kt) do { _Pragma("unroll") for (int h2 = 0; h2 < 2; ++h2) { const int kk = (kt) * AT_TK + h2 * 64 + lkey; \
        const size_t row = kk < SEQ ? (size_t)b * SEQ + kk : (size_t)MLAT + b * LCTX + (kk - SEQ); kreg[h2] = *(const GAS v4u*)(kcol + row * NPROJ); vreg[h2] = *(const GAS v4u*)(vcol + row * NPROJ); } } while (0)
#define AT_STORE(buf) do { _Pragma("unroll") for (int h2 = 0; h2 < 2; ++h2) { *(LAS v4u*)(KB + (buf) * AT_KBYTES + h2 * 64 * AT_KSTR + kwoff) = kreg[h2]; \
        *(LAS v4u*)(VB + (buf) * AT_VBYTES + h2 * 64 * AT_VSTR + vwoff) = vreg[h2]; } } while (0)
#define AT_QK(P0, P1, Kc, DYN) do { { const bf16x8 a0 = *(const LAS bf16x8*)(Kc), a1 = *(const LAS bf16x8*)((Kc) + 32 * AT_KSTR), q = (DYN) ? *(const LAS bf16x8*)(QP) : qf_in[0]; \
            P0 = MFMA32(a0, q, (DYN) ? negm : zero16); P1 = MFMA32(a1, q, (DYN) ? negm : zero16); } \
        _Pragma("unroll") for (int d0 = 1; d0 < 4; ++d0) { const bf16x8 a0 = *(const LAS bf16x8*)((Kc) + d0 * 32), a1 = *(const LAS bf16x8*)((Kc) + 32 * AT_KSTR + d0 * 32), q = (DYN) ? *(const LAS bf16x8*)(QP + d0 * 1024) : qf_in[d0]; \
            P0 = MFMA32(a0, q, P0); P1 = MFMA32(a1, q, P1); } } while (0)
#define AT_STEP(C0, C1, N0, N1, Kn, Vc, HASN, DYN) do { if (DYN) { \
        float mxa = max3f(C0[0], C0[1], C1[0]), mxb = max3f(C0[2], C0[3], C1[1]); mxa = max3f(mxa, C1[2], C1[3]); \
        _Pragma("unroll") for (int r = 4; r < 16; r += 4) { mxa = max3f(mxa, C0[r], C0[r + 1]); mxb = max3f(mxb, C0[r + 2], C0[r + 3]); mxa = max3f(mxa, C1[r], C1[r + 1]); mxb = max3f(mxb, C1[r + 2], C1[r + 3]); } \
        float mx = max3f(mxa, mxb, mxb); mx = max3f(mx, __shfl_xor(mx, 32), mx); \
        if (first || __any(mx > AT_THR)) { const float dl = first ? mx : fmaxf(mx, 0.f); m += dl; const float alpha = __builtin_amdgcn_exp2f(-dl); \
            _Pragma("unroll") for (int r = 0; r < 16; ++r) { C0[r] -= dl; C1[r] -= dl; o0[r] *= alpha; o1[r] *= alpha; negm[r] = -m; } \
            lsum *= alpha; first = false; } } \
        if (HASN) AT_QK(N0, N1, Kn, DYN); \
        float rs = 0.f; \
        _Pragma("unroll") for (int r = 0; r < 16; ++r) { C0[r] = __builtin_amdgcn_exp2f(C0[r]); C1[r] = __builtin_amdgcn_exp2f(C1[r]); rs += C0[r] + C1[r]; } \
        lsum += rs; \
        bf16x8 pf[4]; \
        _Pragma("unroll") for (int s = 0; s < 4; ++s) { v4u w; \
            _Pragma("unroll") for (int e = 0; e < 4; ++e) { const int r = 8 * (s & 1) + 2 * e; w[e] = (s < 2) ? pk2(C0[r], C0[r + 1]) : pk2(C1[r], C1[r + 1]); } \
            pf[s] = __builtin_bit_cast(bf16x8, w); } \
        _Pragma("unroll") for (int s = 0; s < 4; ++s) { \
            const s16x4 a_lo = tr16((Vc) + (16 * s) * AT_VSTR), a_hi = tr16((Vc) + (16 * s + 8) * AT_VSTR); \
            const s16x4 b_lo = tr16((Vc) + (16 * s) * AT_VSTR + 64), b_hi = tr16((Vc) + (16 * s + 8) * AT_VSTR + 64); \
            o0 = MFMA32(CAT8(a_lo, a_hi), pf[s], o0); o1 = MFMA32(CAT8(b_lo, b_hi), pf[s], o1); } } while (0)
#define AT_FENCE __builtin_amdgcn_sched_barrier(0)
#define AT_E(C, r) do { C[r] = __builtin_amdgcn_exp2f(C[r]); C[(r) + 1] = __builtin_amdgcn_exp2f(C[(r) + 1]); } while (0)
#define AT_A(C, r, W) do { rs += C[r]; rs2 += C[(r) + 1]; W = pk2(C[r], C[(r) + 1]); } while (0)
#define AT_VRD(V, s) do { V[0] = tr16((Vc_) + (16 * (s)) * AT_VSTR); V[1] = tr16((Vc_) + (16 * (s) + 8) * AT_VSTR); V[2] = tr16((Vc_) + (16 * (s)) * AT_VSTR + 64); V[3] = tr16((Vc_) + (16 * (s) + 8) * AT_VSTR + 64); } while (0)
#define AT_STEP_S(C0, C1, N0, N1, Kn, Vc, HASN) do { \
        const LAS unsigned char* Vc_ = (Vc); bf16x8 ka[4], kb[4]; s16x4 va[4], vb[4]; v4u w0, w1, w2, w3; float rs = 0.f, rs2 = 0.f; \
        if (HASN) { _Pragma("unroll") for (int d0 = 0; d0 < 4; ++d0) { ka[d0] = *(const LAS bf16x8*)((Kn) + d0 * 32); kb[d0] = *(const LAS bf16x8*)((Kn) + 32 * AT_KSTR + d0 * 32); } } \
        AT_FENCE; AT_E(C0, 0); \
        AT_FENCE; AT_VRD(va, 0); AT_E(C0, 2); AT_A(C0, 0, w0[0]); \
        AT_FENCE; if (HASN) N0 = MFMA32(ka[0], qf_in[0], zero16); AT_E(C0, 4); AT_A(C0, 2, w0[1]); \
        AT_FENCE; if (HASN) N1 = MFMA32(kb[0], qf_in[0], zero16); AT_E(C0, 6); AT_A(C0, 4, w0[2]); \
        AT_FENCE; if (HASN) N0 = MFMA32(ka[1], qf_in[1], N0); AT_E(C0, 8); AT_A(C0, 6, w0[3]); \
        AT_FENCE; if (HASN) N1 = MFMA32(kb[1], qf_in[1], N1); AT_VRD(vb, 1); AT_E(C0, 10); AT_A(C0, 8, w1[0]); \
        AT_FENCE; o0 = MFMA32(CAT8(va[0], va[1]), __builtin_bit_cast(bf16x8, w0), o0); AT_E(C0, 12); AT_A(C0, 10, w1[1]); \
        AT_FENCE; o1 = MFMA32(CAT8(va[2], va[3]), __builtin_bit_cast(bf16x8, w0), o1); AT_E(C0, 14); AT_A(C0, 12, w1[2]); \
        AT_FENCE; if (HASN) N0 = MFMA32(ka[2], qf_in[2], N0); AT_E(C1, 0); AT_A(C0, 14, w1[3]); \
        AT_FENCE; if (HASN) N1 = MFMA32(kb[2], qf_in[2], N1); AT_VRD(va, 2); AT_E(C1, 2); AT_A(C1, 0, w2[0]); \
        AT_FENCE; o0 = MFMA32(CAT8(vb[0], vb[1]), __builtin_bit_cast(bf16x8, w1), o0); AT_E(C1, 4); AT_A(C1, 2, w2[1]); \
        AT_FENCE; o1 = MFMA32(CAT8(vb[2], vb[3]), __builtin_bit_cast(bf16x8, w1), o1); AT_E(C1, 6); AT_A(C1, 4, w2[2]); \
        AT_FENCE; if (HASN) N0 = MFMA32(ka[3], qf_in[3], N0); AT_E(C1, 8); AT_A(C1, 6, w2[3]); \
        AT_FENCE; if (HASN) N1 = MFMA32(kb[3], qf_in[3], N1); AT_VRD(vb, 3); AT_E(C1, 10); AT_A(C1, 8, w3[0]); \
        AT_FENCE; o0 = MFMA32(CAT8(va[0], va[1]), __builtin_bit_cast(bf16x8, w2), o0); AT_E(C1, 12); AT_A(C1, 10, w3[1]); \
        AT_FENCE; o1 = MFMA32(CAT8(va[2], va[3]), __builtin_bit_cast(bf16x8, w2), o1); AT_E(C1, 14); AT_A(C1, 12, w3[2]); \
        AT_FENCE; AT_A(C1, 14, w3[3]); o0 = MFMA32(CAT8(vb[0], vb[1]), __builtin_bit_cast(bf16x8, w3), o0); o1 = MFMA32(CAT8(vb[2], vb[3]), __builtin_bit_cast(bf16x8, w3), o1); lsum += rs + rs2; \
        AT_FENCE; } while (0)
    AT_LOAD(kt0);
    __syncthreads();
#pragma unroll
    for (int d0 = 0; d0 < 4; ++d0) *(LAS bf16x8*)(QP + d0 * 1024) = qf_in[d0];
    AT_STORE(0);
    if (nkt > 1) AT_LOAD(kt0 + 1);
    __syncthreads();
    bool first = true;
    f32x16 pA0, pA1, pB0, pB1;
    float Mb;
    { float gq = fabsf(((const GAS float*)qn)[lane]), gk = fabsf(((const GAS float*)kn)[lane]);
#pragma unroll
      for (int o = 1; o < 64; o <<= 1) { gq = fmaxf(gq, __shfl_xor(gq, o)); gk = fmaxf(gk, __shfl_xor(gk, o)); }
      Mb = 8.25f * LOG2E * gq * gk; }
#define AT_LOOP(DYN) do { \
    AT_QK(pA0, pA1, KB + kroff, DYN); \
    for (int t = 0; t < nkt; ++t) { \
        const int cur = t & 1; \
        if (t + 1 < nkt) AT_STORE(cur ^ 1); \
        if (t + 2 < nkt) AT_LOAD(kt0 + t + 2); \
        const LAS unsigned char* Kc = KB + cur * AT_KBYTES + kroff; const LAS unsigned char* Vc = VB + cur * AT_VBYTES + vroff; \
        AT_STEP(pA0, pA1, pB0, pB1, Kc + 64 * AT_KSTR, Vc, true, DYN); \
        __syncthreads(); \
        const LAS unsigned char* Kn = KB + (cur ^ 1) * AT_KBYTES + kroff; \
        AT_STEP(pB0, pB1, pA0, pA1, Kn, Vc + 64 * AT_VSTR, (t + 1 < nkt), DYN); \
        __syncthreads(); \
    } } while (0)
#define AT_LOOP_S() do { \
    AT_QK(pA0, pA1, KB + kroff, 0); \
    for (int t = 0; t < nkt; ++t) { \
        const int cur = t & 1; \
        if (t + 1 < nkt) AT_STORE(cur ^ 1); \
        if (t + 2 < nkt) AT_LOAD(kt0 + t + 2); \
        const LAS unsigned char* Kc = KB + cur * AT_KBYTES + kroff; const LAS unsigned char* Vc = VB + cur * AT_VBYTES + vroff; \
        AT_STEP_S(pA0, pA1, pB0, pB1, Kc + 64 * AT_KSTR, Vc, true); \
        __syncthreads(); \
        const LAS unsigned char* Kn = KB + (cur ^ 1) * AT_KBYTES + kroff; \
        AT_STEP_S(pB0, pB1, pA0, pA1, Kn, Vc + 64 * AT_VSTR, (t + 1 < nkt)); \
        __syncthreads(); \
    } } while (0)
    if (Mb < 60.f) AT_LOOP_S();
    else AT_LOOP(1);
#undef AT_LOOP
#undef AT_LOOP_S
#undef AT_STEP_S
#undef AT_E
#undef AT_A
#undef AT_VRD
#undef AT_FENCE
#undef AT_QK
#undef AT_STEP
#undef AT_LOAD
#undef AT_STORE
    lsum += __shfl_xor(lsum, 32);
    const float inv = 1.f / lsum;
    GAS bf16* op = MIXAg + (size_t)(qrow0 + wave * 32 + r32) * DM + hq * 64 + 8 * hi;
#pragma unroll
    for (int p = 0; p < 2; ++p) {
#pragma unroll
        for (int h2 = 0; h2 < 2; ++h2) {
            const int ga = 8 * p, gb = 8 * p + 4;
            unsigned ax, ay, bx, by;
            if (h2 == 0) { ax = pk2(o0[ga] * inv, o0[ga + 1] * inv); ay = pk2(o0[ga + 2] * inv, o0[ga + 3] * inv); bx = pk2(o0[gb] * inv, o0[gb + 1] * inv); by = pk2(o0[gb + 2] * inv, o0[gb + 3] * inv); }
            else         { ax = pk2(o1[ga] * inv, o1[ga + 1] * inv); ay = pk2(o1[ga + 2] * inv, o1[ga + 3] * inv); bx = pk2(o1[gb] * inv, o1[gb + 1] * inv); by = pk2(o1[gb + 2] * inv, o1[gb + 3] * inv); }
            const auto r0 = __builtin_amdgcn_permlane32_swap(ax, bx, false, false); const auto r1 = __builtin_amdgcn_permlane32_swap(ay, by, false, false);
            v4u w; w.x = r0[0]; w.y = r1[0]; w.z = r0[1]; w.w = r1[1];
            *(GAS v4u*)(op + 32 * h2 + 16 * p) = w;
        }
    }
}
template <int N>
__device__ __forceinline__ void rec_unit(LAS unsigned char* lds, int tid, int lane, int wave,
                                         const bf16* Qg, const bf16* Kg, const bf16* Vg, int pitch,
                                         const float* dtla, int dt_off, int la_off, float la_const,
                                         bf16* Yg, int ypitch, int b, bool rev, bool ctx_out) {
    constexpr int QSTR = N * 2 + 16, VSTR = 144;
    constexpr int KB_ = 128 * QSTR, VB_ = 128 * VSTR, SB_ = 64 * QSTR, FB_ = 2560;
    constexpr int OFF_K = 0, OFF_V = 2 * KB_, OFF_S = OFF_V + 2 * VB_, OFF_F = OFF_S + 2 * SB_;
    static_assert(OFF_F + 2 * FB_ <= LDSCTL_OFF, "rec_unit LDS map");
    constexpr int NT = N / 16, KS = N / 32, TPW = NT / 2, CPR = N / 8, NLD = CPR / 4;
    const int c = lane & 15, quad = lane >> 4, q4 = c >> 2, p4 = c & 3;
    const GAS bf16* Qgg = (const GAS bf16*)Qg; const GAS bf16* Kgg = (const GAS bf16*)Kg; const GAS bf16* Vgg = (const GAS bf16*)Vg; const GAS float* dtg = (const GAS float*)dtla; GAS bf16* Ygg = (GAS bf16*)Yg;
    const int own_nt = wave % NT, own_pt0 = (wave / NT) * TPW;
    const int itile = wave < 4 ? wave : 11 - wave;
    const int icol = 16 * itile + c;
    f32x4 sacc[TPW];
#pragma unroll
    for (int i = 0; i < TPW; ++i) sacc[i] = (f32x4){0.f, 0.f, 0.f, 0.f};
    v4u rk[NLD], rv[2]; bf16x8 qn[KS]; float la0 = la_const, la1 = la_const, s0 = 1.f, s1 = 1.f;
#define RC_GEOM(ci_) const bool isctx_ = (ci_) < 2; const int cc_ = isctx_ ? (ci_) : (ci_) - 2; const int sbase_ = isctx_ ? MLAT + b * LCTX : b * SEQ, slen_ = isctx_ ? LCTX : SEQ; \
        const int pos0_ = rev ? (slen_ - 1 - cc_ * 128) : cc_ * 128, pstep_ = rev ? -1 : 1;
#define RC_LOAD(ci_) do { RC_GEOM(ci_) \
        _Pragma("unroll") for (int k = 0; k < NLD; ++k) { const int idx = tid + k * 512, ip = idx / CPR, ch = idx % CPR; const size_t row = (size_t)(sbase_ + pos0_ + pstep_ * ip); \
            rk[k] = *(const GAS v4u*)(Kgg + row * pitch + ch * 8); } \
        _Pragma("unroll") for (int k = 0; k < 2; ++k) { const int idx = tid + k * 512, ip = idx >> 3, ch = idx & 7; const size_t row = (size_t)(sbase_ + pos0_ + pstep_ * ip); \
            rv[k] = *(const GAS v4u*)(Vgg + row * pitch + ch * 8); } \
        { const GAS bf16* qp = Qgg + (size_t)(sbase_ + pos0_ + pstep_ * icol) * pitch + quad * 8; \
          _Pragma("unroll") for (int ks = 0; ks < KS; ++ks) qn[ks] = *(const GAS bf16x8*)(qp + ks * 32); } \
        if (wave == 0 && dtla) { const size_t r0 = (size_t)(sbase_ + pos0_ + pstep_ * (2 * lane)), r1 = (size_t)(sbase_ + pos0_ + pstep_ * (2 * lane + 1)); \
            la0 = dtg[r0 * 24 + la_off]; la1 = dtg[r1 * 24 + la_off]; s0 = dtg[r0 * 24 + dt_off]; s1 = dtg[r1 * 24 + dt_off]; } } while (0)
#define RC_STORE(bf_) do { \
        _Pragma("unroll") for (int k = 0; k < NLD; ++k) { const int idx = tid + k * 512, ip = idx / CPR, ch = idx % CPR; *(LAS v4u*)(lds + OFF_K + (bf_) * KB_ + ip * QSTR + ch * 16) = rk[k]; } \
        _Pragma("unroll") for (int k = 0; k < 2; ++k) { const int idx = tid + k * 512, ip = idx >> 3, ch = idx & 7; *(LAS v4u*)(lds + OFF_V + (bf_) * VB_ + ip * VSTR + ch * 16) = rv[k]; } } while (0)
#define RC_CUM(bf_) do { if (wave == 0) { LAS float* CUMw = (LAS float*)(lds + OFF_F + (bf_) * FB_); \
            const float pair = la0 + la1; float v = pair; \
            _Pragma("unroll") for (int o = 1; o < 64; o <<= 1) { const float t = __shfl_up(v, o); if (lane >= o) v += t; } \
            const float c1 = v, c0 = (v - pair) + la0, last = __shfl(v, 63); \
            CUMw[2 * lane] = c0 * LOG2E; CUMw[2 * lane + 1] = c1 * LOG2E; \
            CUMw[128 + 2 * lane] = __expf(c0); CUMw[128 + 2 * lane + 1] = __expf(c1); \
            CUMw[256 + 2 * lane] = s0 * __expf(last - c0); CUMw[256 + 2 * lane + 1] = s1 * __expf(last - c1); \
            CUMw[384 + 2 * lane] = s0; CUMw[384 + 2 * lane + 1] = s1; \
            if (lane == 0) CUMw[512] = __expf(last); } } while (0)
    RC_LOAD(0);
    __syncthreads();
    for (int i = tid; i < SB_ / 4; i += NWAVES * 64) ((LAS unsigned*)(lds + OFF_S))[i] = 0u;
    RC_STORE(0); RC_CUM(0);
    bf16x8 qf[KS];
#pragma unroll
    for (int ks = 0; ks < KS; ++ks) qf[ks] = qn[ks];
    RC_LOAD(1);
    __syncthreads();
    for (int ci = 0; ci < 18; ++ci) {
        RC_GEOM(ci)
        const int cur = ci & 1;
        const LAS unsigned char* Kc = lds + OFF_K + cur * KB_; const LAS unsigned char* Vc = lds + OFF_V + cur * VB_; const LAS unsigned char* Sc = lds + OFF_S + cur * SB_;
        const LAS float* CUM = (const LAS float*)(lds + OFF_F + cur * FB_); const LAS float* ECUM = CUM + 128; const LAS float* WJ = CUM + 256; const LAS float* SJ = CUM + 384;
        const float cum_i = CUM[icol], ecum_i = ECUM[icol];
        const bool want_y = !isctx_ || ctx_out;
        if (want_y) {
            f32x4 ya[4];
            {   bf16x8 sf[4][KS];
#pragma unroll
                for (int pt = 0; pt < 4; ++pt)
#pragma unroll
                    for (int ks = 0; ks < KS; ++ks) sf[pt][ks] = *(const LAS bf16x8*)(Sc + (16 * pt + c) * QSTR + ks * 64 + quad * 16);
#pragma unroll
                for (int pt = 0; pt < 4; ++pt) ya[pt] = (f32x4){0.f, 0.f, 0.f, 0.f};
#pragma unroll
                for (int ks = 0; ks < KS; ++ks)
#pragma unroll
                    for (int pt = 0; pt < 4; ++pt) ya[pt] = MFMA16(sf[pt][ks], qf[ks], ya[pt]);
#pragma unroll
                for (int pt = 0; pt < 4; ++pt) ya[pt] = ya[pt] * ecum_i; }
            const int nkk = (itile >> 1) + 1;
#define RC_YSTEPS(NKK) do { \
            _Pragma("unroll") for (int kk = 0; kk < (NKK); ++kk) { \
                bf16x8 ka[2][KS]; \
                _Pragma("unroll") for (int half = 0; half < 2; ++half) \
                    _Pragma("unroll") for (int ks = 0; ks < KS; ++ks) ka[half][ks] = *(const LAS bf16x8*)(Kc + (32 * kk + 16 * half + c) * QSTR + ks * 64 + quad * 16); \
                f32x4 cj[2], sj[2]; \
                _Pragma("unroll") for (int half = 0; half < 2; ++half) { cj[half] = *(const LAS f32x4*)(CUM + 32 * kk + 16 * half + 4 * quad); sj[half] = *(const LAS f32x4*)(SJ + 32 * kk + 16 * half + 4 * quad); } \
                s16x4 vlo[4], vhi[4]; \
                _Pragma("unroll") for (int pt = 0; pt < 4; ++pt) { const LAS unsigned char* vp = Vc + (32 * kk + 4 * quad + q4) * VSTR + (16 * pt + 4 * p4) * 2; vlo[pt] = tr16(vp); vhi[pt] = tr16(vp + 16 * VSTR); } \
                f32x4 g0 = (f32x4){0.f, 0.f, 0.f, 0.f}, g1 = (f32x4){0.f, 0.f, 0.f, 0.f}; \
                _Pragma("unroll") for (int ks = 0; ks < KS; ++ks) { g0 = MFMA16(ka[0][ks], qf[ks], g0); g1 = MFMA16(ka[1][ks], qf[ks], g1); } \
                v4u w; \
                _Pragma("unroll") for (int half = 0; half < 2; ++half) { const f32x4 gacc = half ? g1 : g0; float pv[4]; \
                    _Pragma("unroll") for (int r = 0; r < 4; ++r) { const int j = 32 * kk + 16 * half + 4 * quad + r; const bool ok = rev ? (j < icol) : (j <= icol); \
                        const float e = __builtin_amdgcn_exp2f(fminf(cum_i - cj[half][r], 0.f)); pv[r] = ok ? gacc[r] * sj[half][r] * e : 0.f; } \
                    w[2 * half] = pk2(pv[0], pv[1]); w[2 * half + 1] = pk2(pv[2], pv[3]); } \
                const bf16x8 pfr = __builtin_bit_cast(bf16x8, w); \
                _Pragma("unroll") for (int pt = 0; pt < 4; ++pt) ya[pt] = MFMA16(CAT8(vlo[pt], vhi[pt]), pfr, ya[pt]); \
            } } while (0)
            if (nkk == 4) RC_YSTEPS(4); else if (nkk == 3) RC_YSTEPS(3); else if (nkk == 2) RC_YSTEPS(2); else RC_YSTEPS(1);
#undef RC_YSTEPS
            GAS bf16* yp = Ygg + (size_t)(sbase_ + pos0_ + pstep_ * icol) * ypitch + 4 * quad;
#pragma unroll
            for (int pt = 0; pt < 4; ++pt) { v2u w; w.x = pk2(ya[pt][0], ya[pt][1]); w.y = pk2(ya[pt][2], ya[pt][3]); *(GAS v2u*)(yp + 16 * pt) = w; }
        }
        if (ci + 1 < 18) { RC_STORE(cur ^ 1); RC_CUM(cur ^ 1);
#pragma unroll
            for (int ks = 0; ks < KS; ++ks) qf[ks] = qn[ks];
            if (ci + 2 < 18) RC_LOAD(ci + 2); }
        { const float dec = CUM[512];
#pragma unroll
          for (int i = 0; i < TPW; ++i) sacc[i] = sacc[i] * dec;
#pragma unroll
          for (int kk = 0; kk < 4; ++kk) {
              const LAS unsigned char* kp = Kc + (32 * kk + 8 * quad + q4) * QSTR + (16 * own_nt + 4 * p4) * 2;
              const s16x4 klo = tr16(kp), khi = tr16(kp + 4 * QSTR);
              const f32x4 w0 = *(const LAS f32x4*)(WJ + 32 * kk + 8 * quad), w1 = *(const LAS f32x4*)(WJ + 32 * kk + 8 * quad + 4);
              v4u kw; kw.x = pk2(bf1((bf16)klo[0]) * w0[0], bf1((bf16)klo[1]) * w0[1]); kw.y = pk2(bf1((bf16)klo[2]) * w0[2], bf1((bf16)klo[3]) * w0[3]);
              kw.z = pk2(bf1((bf16)khi[0]) * w1[0], bf1((bf16)khi[1]) * w1[1]); kw.w = pk2(bf1((bf16)khi[2]) * w1[2], bf1((bf16)khi[3]) * w1[3]);
              const bf16x8 kb = __builtin_bit_cast(bf16x8, kw);
#pragma unroll
              for (int i = 0; i < TPW; ++i) { const LAS unsigned char* vp = Vc + (32 * kk + 8 * quad + q4) * VSTR + (16 * (own_pt0 + i) + 4 * p4) * 2;
                  const s16x4 lo = tr16(vp), hi = tr16(vp + 4 * VSTR); sacc[i] = MFMA16(CAT8(lo, hi), kb, sacc[i]); }
          } }
#pragma unroll
        for (int i = 0; i < TPW; ++i)
#pragma unroll
            for (int r = 0; r < 4; ++r) *(LAS bf16*)(lds + OFF_S + (cur ^ 1) * SB_ + (16 * (own_pt0 + i) + 4 * quad + r) * QSTR + (16 * own_nt + c) * 2) = (bf16)f2bf(sacc[i][r]);
        __syncthreads();
    }
#undef RC_GEOM
#undef RC_LOAD
#undef RC_STORE
#undef RC_CUM
}
__device__ __forceinline__ void finish_rows(const Args& A, unsigned char* ws, int layer, int m0, int m1, int mstep, int lane) {
    const bf16* PROJ = (const bf16*)(ws + WS_BIG); const bf16* XBC2 = (const bf16*)(ws + WS_XBC2);
    bf16* MIXA = (bf16*)(ws + WS_XN);
    const int Mrows = layer == 0 ? MALL : MLAT;
    const bf16* Yret = (const bf16*)A.out; const bf16* Yssd = Yret + (size_t)2 * Mrows * 256;
    const f32x4 gg = *(const f32x4*)(A.in[12] + layer * 256 + 4 * lane), gb = *(const f32x4*)(A.in[13] + layer * 256 + 4 * lane);
    const int l8 = lane < 48 ? lane : 0;
    const float dsk = A.in[18][layer * 6 + (l8 >> 3)];
    const f32x4 ng0 = *(const f32x4*)(A.in[19] + layer * 384 + 8 * l8), ng1 = *(const f32x4*)(A.in[19] + layer * 384 + 8 * l8 + 4);
#pragma unroll 2
    for (int m = m0; m < m1; m += mstep) {
        {
            const v2u a = __builtin_nontemporal_load((const v2u*)(Yret + (size_t)m * 256 + 4 * lane)), bq = __builtin_nontemporal_load((const v2u*)(Yret + ((size_t)Mrows + m) * 256 + 4 * lane));
            const v2u gq = __builtin_nontemporal_load((const v2u*)(PROJ + (size_t)m * NPROJ + C_GR + 4 * lane));
            float y[4] = {bflo(a.x) + bflo(bq.x), bfhi(a.x) + bfhi(bq.x), bflo(a.y) + bflo(bq.y), bfhi(a.y) + bfhi(bq.y)};
            const float gv[4] = {bflo(gq.x), bfhi(gq.x), bflo(gq.y), bfhi(gq.y)};
            const float mu = sum16((y[0] + y[1]) + (y[2] + y[3])) * (1.f / 64.f);
            float d[4], q = 0.f;
#pragma unroll
            for (int e = 0; e < 4; ++e) { d[e] = y[e] - mu; q += d[e] * d[e]; }
            const float rstd = rsqrtf(sum16(q) * (1.f / 64.f) + EPS);
            float o[4];
#pragma unroll
            for (int e = 0; e < 4; ++e) o[e] = (d[e] * rstd * gg[e] + gb[e]) * silu_f(gv[e]);
            v2u w; w.x = pk2(o[0], o[1]); w.y = pk2(o[2], o[3]); *(v2u*)(MIXA + (size_t)m * DM + 384 + 4 * lane) = w;
        }
        {
            float u[8]; float ss = 0.f;
            if (lane < 48) {
                const v4u a = __builtin_nontemporal_load((const v4u*)(Yssd + (size_t)m * 384 + 8 * lane)), bq = __builtin_nontemporal_load((const v4u*)(Yssd + ((size_t)Mrows + m) * 384 + 8 * lane));
                const v4u xs = __builtin_nontemporal_load((const v4u*)(XBC2 + (size_t)m * XBW + 8 * lane)), z = __builtin_nontemporal_load((const v4u*)(PROJ + (size_t)m * NPROJ + C_Z + 8 * lane));
#pragma unroll
                for (int e2 = 0; e2 < 4; ++e2) { const float y0 = bflo(a[e2]) + bflo(bq[e2]) + dsk * bflo(xs[e2]), y1 = bfhi(a[e2]) + bfhi(bq[e2]) + dsk * bfhi(xs[e2]);
                    u[2 * e2] = y0 * silu_f(bflo(z[e2])); u[2 * e2 + 1] = y1 * silu_f(bfhi(z[e2])); ss += u[2 * e2] * u[2 * e2] + u[2 * e2 + 1] * u[2 * e2 + 1]; }
            } else {
#pragma unroll
                for (int e = 0; e < 8; ++e) u[e] = 0.f;
            }
            const float rstd = rsqrtf(wave_sum(ss) * (1.f / 384.f) + EPS);
            if (lane < 48) { v4u w; w.x = pk2(u[0] * rstd * ng0[0], u[1] * rstd * ng0[1]); w.y = pk2(u[2] * rstd * ng0[2], u[3] * rstd * ng0[3]);
                w.z = pk2(u[4] * rstd * ng1[0], u[5] * rstd * ng1[1]); w.w = pk2(u[6] * rstd * ng1[2], u[7] * rstd * ng1[3]);
                *(v4u*)(MIXA + (size_t)m * DM + 640 + 8 * lane) = w; }
        }
    }
}

constexpr int U_SSD = 96, U_RET = 64, U_ATT = 384, U_CATT = 48, FIN_ROWS = 32;
__device__ __forceinline__ void mixer_phase(Frame& F, const Args& A, int layer, int rep) {
    const bool ctx_out = layer == 0; const int Mrows = ctx_out ? MALL : MLAT;
    const int n_mix = U_SSD + U_RET + U_ATT + (ctx_out ? U_CATT : 0), total = n_mix + Mrows / FIN_ROWS;
    gu32* recdone = F.ctl + CW_FLAGS + 64 * 8 * (layer + 2 * rep);
    gu32* qword = F.ctl + CW_QUEUE + 64 * layer + 128 * rep;
    for (;;) {
        if (F.tid == 0) F.MISC[16] = __hip_atomic_fetch_add(qword, 1u, RLX_AGENT);
        __syncthreads();
        const int uq = (int)F.MISC[16];
        __syncthreads();
#ifdef REP_ONLY_REC
        if (rep > 0 && (uq >= U_SSD + U_RET && uq < n_mix)) continue;
#endif
#ifdef REP_ONLY_ATT
        if (rep > 0 && (uq < U_SSD + U_RET || uq >= n_mix)) continue;
#endif
        if (uq >= total) break;
        int tid = F.tid; asm volatile("" : "+v"(tid));
        const int lane = tid & 63, wave = __builtin_amdgcn_readfirstlane(tid >> 6);
        unsigned char* wsb = A.ws; asm volatile("" : "+s"(wsb));
        const int u = uq;
        const bf16* PROJ = (const bf16*)(wsb + WS_BIG); const bf16* XBC2 = (const bf16*)(wsb + WS_XBC2); const float* DTLA = (const float*)(wsb + WS_DTLA);
        bf16* MIXA = (bf16*)(wsb + WS_XN);
        bf16* Yret = (bf16*)A.out; bf16* Yssd = Yret + (size_t)2 * Mrows * 256;
#define REC_PUBLISH(b_) do { asm volatile("s_waitcnt vmcnt(0)" ::: "memory"); __syncthreads(); \
            if (tid == 0) { __builtin_amdgcn_fence(__ATOMIC_RELEASE, "agent"); asm volatile("s_waitcnt vmcnt(0)" ::: "memory"); __hip_atomic_fetch_add(recdone + 64 * (b_), 1u, RLX_AGENT); } } while (0)
        if (u >= n_mix) {
            const int row0 = (u - n_mix) * FIN_ROWS, b = row0 < MLAT ? row0 >> 11 : (row0 - MLAT) >> 8;
            if (tid == 0) { unsigned sp = 0; while (__hip_atomic_load(recdone + 64 * b, RLX_AGENT) < 20u && ++sp < (1u << 24)) __builtin_amdgcn_s_sleep(4);
                __builtin_amdgcn_fence(__ATOMIC_ACQUIRE, "agent"); asm volatile("s_waitcnt vmcnt(0)" ::: "memory"); }
            __syncthreads();
            finish_rows(A, wsb, layer, row0 + wave, row0 + FIN_ROWS, NWAVES, lane);
            continue;
        }
        if (u < U_SSD) {
            const int b = u / 12, h = (u % 12) >> 1, dir = u & 1, g = h / 3;
            rec_unit<128>(F.lds, tid, lane, wave, XBC2 + 640 + g * 128, XBC2 + 384 + g * 128, XBC2 + h * 64, XBW,
                          DTLA, dir * 6 + h, 12 + dir * 6 + h, 0.f, Yssd + (size_t)dir * Mrows * 384 + h * 64, 384, b, dir == 1, ctx_out);
            REC_PUBLISH(b);
        } else if (u < U_SSD + U_RET) {
            const int v = u - U_SSD, b = v >> 3, h = (v & 7) >> 1, dir = v & 1;
            const float dl = A.in[11][layer * 8 + dir * 4 + h];
            const float lg = fminf(dl, 0.f) - log1pf(expf(-fabsf(dl)));
            rec_unit<64>(F.lds, tid, lane, wave, PROJ + C_QR + h * 64, PROJ + C_KR + h * 64, PROJ + C_VR + h * 64, NPROJ,
                         nullptr, 0, 0, lg, Yret + (size_t)dir * Mrows * 256 + h * 64, 256, b, dir == 1, ctx_out);
            REC_PUBLISH(b);
        } else {
            const int v = u - U_SSD - U_RET; const bool isc = v >= U_ATT; const int vc = v - U_ATT;
            const int b = isc ? vc / 6 : v / 48, hq = isc ? vc % 6 : (v % 48) >> 3, qb = v & 7;
            attn_unit(F.lds, PROJ, MIXA, A.in[9] + layer * 64, A.in[10] + layer * 64, b, hq, isc ? MLAT + b * LCTX : b * SEQ + qb * 256, isc ? 16 : 0, isc ? 2 : 18, tid, lane, wave);
        }
    }
}
#ifndef PH_MASK
#define PH_MASK 0xFFFFF
#endif
#define IN(k) (((PH_MASK >> ((k) > 9 ? (k) - 9 : (k))) & 1) && lo <= (k) && (k) < hi)
#ifndef REP_X
#define REP_X 0
#endif
#ifndef REP_GSEL
#define REP_GSEL 0
#endif
#define MKFRAME() Frame F; { int t_ = threadIdx.x; asm volatile("" : "+v"(t_)); F.tid = t_; F.lane = t_ & 63; F.wave = __builtin_amdgcn_readfirstlane(t_ >> 6); F.lds = ldsb; \
    F.MISC = (volatile LAS unsigned*)(ldsb + MISC_OFF); F.ctl = (gu32*)(args.ws + WS_CTL); F.G = gridDim.x; const int bx_ = blockIdx.x; F.vcu = (F.G % 8 == 0) ? (bx_ % 8) * (F.G / 8) + bx_ / 8 : bx_; }
#define SEAM(k) do { if (IN((k) + 1)) xcd_barrier(bar); } while (0)
#define NG (args.in[6] + (size_t)layer * 4 * DM)
#define MODL (MOD + (size_t)layer * 9 * 6144)
#define MOD ((float*)(args.ws + WS_MOD))
#define XN ((bf16*)(args.ws + WS_XN))
#define BIG ((bf16*)(args.ws + WS_BIG))
#define XC ((float*)(args.ws + WS_XC))
#define Win_t ((const bf16*)(args.ws + WS_WIN))
#define Wout_t ((const bf16*)(args.ws + WS_WOUT))
#define W1_t ((const bf16*)(args.ws + WS_W1))
#define W2_t ((const bf16*)(args.ws + WS_W2))
#define SLAB ((bf16*)args.out)
#define XB ((bf16*)(args.ws + WS_XB))
template <int layer>
__device__ __forceinline__ void layer_body(LAS unsigned char* ldsb, const Args& args, const XcdBarrier& bar, const int lo, const int hi) {
        const int pb = 1 + 9 * layer; const int Mrows = layer == 0 ? MALL : MLAT;

        if (IN(pb + 0)) { MKFRAME();
            RowPass P;
            if (layer == 0) P = RowPass{args.in[0], args.in[2], nullptr, nullptr, nullptr, XN, nullptr, nullptr, NG, MODL + 1024, MODL, MALL, nullptr};
            else { P = RowPass{XB, XC, XN, XB, nullptr, XN, MOD + 5120, args.in[6] + 3 * DM, NG, MODL + 1024, MODL, MALL, SLAB}; }
            row_pass<layer, 1, true>(F, P);
#if (REP_X & 2)
            if (layer == 0) { xcd_barrier(bar); row_pass<layer, 1, true>(F, P); }
#endif
            SEAM(pb + 0);
        }
        if (IN(pb + 1)) { MKFRAME();
            pg8::Gemm g{XN, Win_t, MALL, NPROJ, DM, DM}; pg8::StaticOrder S; S.init(MALL, NPROJ, F.G, (int)blockIdx.x, DM / 64);
            fill_rope_table(F);
            EpiProj E{BIG, args.in[9] + layer * 64, args.in[10] + layer * 64, (const LAS float*)(F.lds + ROPE_LDS_OFF)};
            pg8::gemm_phase<EpiProj, pg8::StaticOrder, true, true>(F.lds + RING_OFF, g, S, E);
#if (REP_GSEL & 1)
            xcd_barrier(bar); pg8::gemm_phase<EpiProj, pg8::StaticOrder, true, true>(F.lds + RING_OFF, g, S, E);
#endif
            convert_weights(F, args, layer, 1);
            SEAM(pb + 1);
        }
        if (IN(pb + 2)) { MKFRAME(); prep_rows(args, args.ws, layer, 0, MALL, F.vcu * (NWAVES * 64) + F.tid, F.G * NWAVES * 64);
#if (REP_X & 16)
            xcd_barrier(bar); prep_rows(args, args.ws, layer, 0, MALL, F.vcu * (NWAVES * 64) + F.tid, F.G * NWAVES * 64);
#endif
            SEAM(pb + 2); }
        if (IN(pb + 3)) { MKFRAME(); mixer_phase(F, args, layer, 0);
#ifdef REP_D
            for (int rep = 1; rep <= REP_D; ++rep) { xcd_barrier(bar); mixer_phase(F, args, layer, rep); }
#endif
            if (IN(pb + 5)) xcd_barrier(bar); }
        if (IN(pb + 5)) { MKFRAME();
            pg8::Gemm g{XN, Wout_t, Mrows, DM, DM, DM}; pg8::StaticOrder S; S.init(MLAT, DM, F.G, (int)blockIdx.x, DM / 64);
            pg8::EpiStore<0> E{BIG, DM, SLAB, (size_t)MCTX * DM, MLAT};
            if constexpr (layer == 0) {
                pg8::SplitKOrder K; K.init(MLAT / 256, MCTX / 256, DM / 256, 8, DM / 8, F.G, (int)blockIdx.x); pg8::ComboOrder C; C.init(S, K);
                pg8::gemm_phase<pg8::EpiStore<0>, pg8::ComboOrder, true, true>(F.lds + RING_OFF, g, C, E);
            } else pg8::gemm_phase<pg8::EpiStore<0>, pg8::StaticOrder, true, true>(F.lds + RING_OFF, g, S, E);
#if (REP_GSEL & 2)
            xcd_barrier(bar); if constexpr (layer == 0) {
                pg8::SplitKOrder K; K.init(MLAT / 256, MCTX / 256, DM / 256, 8, DM / 8, F.G, (int)blockIdx.x); pg8::ComboOrder C; C.init(S, K);
                pg8::gemm_phase<pg8::EpiStore<0>, pg8::ComboOrder, true, true>(F.lds + RING_OFF, g, C, E);
            } else pg8::gemm_phase<pg8::EpiStore<0>, pg8::StaticOrder, true, true>(F.lds + RING_OFF, g, S, E);
#endif
            SEAM(pb + 5);
        }
        if (IN(pb + 6)) { MKFRAME();
            RowPass P{layer == 0 ? (const void*)args.in[0] : (const void*)XB, layer == 0 ? args.in[2] : XC, BIG, XB, layer == 0 ? XC : nullptr, XN, MODL + 2048, NG + DM, NG + 2 * DM, MODL + 4096, MODL + 3072, Mrows, layer == 0 ? SLAB : nullptr};
            row_pass<layer, 1>(F, P);
#if (REP_X & 8)
            if (layer == 0) { xcd_barrier(bar); row_pass<layer, 1>(F, P); }
#endif
            SEAM(pb + 6);
        }
        if (IN(pb + 7)) { MKFRAME();
            pg8::Gemm g{XN, W1_t, Mrows, DFF, DM, DM}; pg8::StaticOrder S; S.init(Mrows, DFF, F.G, (int)blockIdx.x, DM / 64);
            pg8::EpiStore<2> E{BIG, DFF, nullptr, 0, 0};
            pg8::gemm_phase<pg8::EpiStore<2>, pg8::StaticOrder, true, true>(F.lds + RING_OFF, g, S, E);
            if constexpr (layer == 0) convert_weights(F, args, 1, 2);
#if (REP_GSEL & 4)
            xcd_barrier(bar); pg8::gemm_phase<pg8::EpiStore<2>, pg8::StaticOrder, true, true>(F.lds + RING_OFF, g, S, E);
#endif
            SEAM(pb + 7);
        }
        if (IN(pb + 8)) { MKFRAME();
            pg8::Gemm g{BIG, W2_t, Mrows, DM, DFF, DFF}; pg8::StaticOrder S; S.init(MLAT, DM, F.G, (int)blockIdx.x, DFF / 64);
            pg8::EpiStore<0> E{XN, DM, SLAB, (size_t)MCTX * DM, MLAT};
            if constexpr (layer == 0) {
                pg8::SplitKOrder K; K.init(MLAT / 256, MCTX / 256, DM / 256, 8, DFF / 8, F.G, (int)blockIdx.x); pg8::ComboOrder C; C.init(S, K);
                pg8::gemm_phase<pg8::EpiStore<0>, pg8::ComboOrder, true, true>(F.lds + RING_OFF, g, C, E);
            } else pg8::gemm_phase<pg8::EpiStore<0>, pg8::StaticOrder, true, true>(F.lds + RING_OFF, g, S, E);
#if (REP_GSEL & 8)
            xcd_barrier(bar); if constexpr (layer == 0) {
                pg8::SplitKOrder K; K.init(MLAT / 256, MCTX / 256, DM / 256, 8, DFF / 8, F.G, (int)blockIdx.x); pg8::ComboOrder C; C.init(S, K);
                pg8::gemm_phase<pg8::EpiStore<0>, pg8::ComboOrder, true, true>(F.lds + RING_OFF, g, C, E);
            } else pg8::gemm_phase<pg8::EpiStore<0>, pg8::StaticOrder, true, true>(F.lds + RING_OFF, g, S, E);
#endif
            SEAM(pb + 8);
        }
    }
__global__ void __launch_bounds__(NWAVES * 64, 2) fwd_kernel(Args args) {
    extern __shared__ __attribute__((aligned(16))) unsigned char lds[];
    LAS unsigned char* ldsb = (LAS unsigned char*)lds;
    for (int u = threadIdx.x; u < (LDS_BYTES - LDSCTL_OFF) / 4; u += NWAVES * 64) ((LAS unsigned*)(ldsb + LDSCTL_OFF))[u] = 0u;
    __syncthreads();
    XcdBarrier bar; bar.bar = (unsigned*)((gu32*)(args.ws + WS_CTL) + CW_BAR); bar.x = 0; bar.st = nullptr;
    if (!MK_PER_PHASE) bar = xcd_barrier_post((unsigned*)((gu32*)(args.ws + WS_CTL) + CW_BAR), (volatile LAS unsigned*)(ldsb + MISC_OFF) + 8);
    const int lo = args.ph_lo, hi = args.ph_hi;

    if (IN(0)) { MKFRAME(); mod_phase(F, args); convert_weights(F, args, 0, 0);
        SEAM(0); }
    layer_body<0>(ldsb, args, bar, lo, hi);
    layer_body<1>(ldsb, args, bar, lo, hi);
#ifdef REP_BAR
    for (int rb = 0; rb < REP_BAR; ++rb) xcd_barrier(bar);
#endif
    if (IN(19)) { MKFRAME();
        RowPass P{XB, XC, XN, args.out, nullptr, nullptr, MOD + 9 * 6144 + 5120, args.in[6] + 7 * DM, nullptr, nullptr, nullptr, MLAT, nullptr};
        row_pass<1, 0>(F, P);
    }
}

extern "C" void kernel_launch(void* const* d_in, const int* in_sizes, int n_in, void* d_out, int out_size, void* d_ws, size_t ws_size, hipStream_t stream) {
    static int grid = 0;
    if (grid == 0) {
        if (n_in != 22 || in_sizes[0] != MLAT * DM || out_size != MLAT * DM || ws_size < WS_END) {
            fprintf(stderr, "kernel_launch: unexpected shapes: n_in %d in0 %d out %d ws %zu; nothing launched\n", n_in, n_in > 0 ? in_sizes[0] : -1, out_size, ws_size); grid = -1; return; }
        int dev = 0, cus = 0, per_cu = 0;
        if (hipGetDevice(&dev) != hipSuccess || hipDeviceGetAttribute(&cus, hipDeviceAttributeMultiprocessorCount, dev) != hipSuccess) { grid = -1; return; }
        if (hipFuncSetAttribute((const void*)fwd_kernel, hipFuncAttributeMaxDynamicSharedMemorySize, LDS_BYTES) != hipSuccess) { fprintf(stderr, "kernel_launch: hipFuncSetAttribute failed\n"); grid = -1; return; }
        if (hipOccupancyMaxActiveBlocksPerMultiprocessor(&per_cu, (const void*)fwd_kernel, NWAVES * 64, LDS_BYTES) != hipSuccess || per_cu < 1)
            fprintf(stderr, "kernel_launch: note: occupancy query reports %d workgroups per CU\n", per_cu);
        (void)hipGetLastError();
        grid = cus;
    }
    if (grid < 0) return;
    if (hipMemsetAsync((char*)d_ws + WS_CTL, 0, CTL_ZERO_BYTES, stream) != hipSuccess) { fprintf(stderr, "kernel_launch: memset failed\n"); return; }
    Args a{};
    for (int i = 0; i < 22; ++i) a.in[i] = (const float*)d_in[i];
    a.out = (float*)d_out; a.ws = (unsigned char*)d_ws;
#if MK_PER_PHASE
    for (int ph = 0; ph < N_PHASES; ++ph) { a.ph_lo = ph; a.ph_hi = ph + 1; a.li = ph;
        hipLaunchKernelGGL(fwd_kernel, dim3(grid), dim3(NWAVES * 64), LDS_BYTES, stream, a); }
#else
    a.ph_lo = 0; a.ph_hi = N_PHASES; a.li = 0;
    hipLaunchKernelGGL(fwd_kernel, dim3(grid), dim3(NWAVES * 64), LDS_BYTES, stream, a);
#endif
    const hipError_t le = hipPeekAtLastError();
    if (le != hipSuccess) fprintf(stderr, "kernel_launch: launch failed: %s\n", hipGetErrorName(le));
}
```

```cpp
#include <hip/hip_runtime.h>
#include <hip/hip_bf16.h>
#include <cstdio>
#include <cstdint>
#ifndef MK_PER_PHASE
#define MK_PER_PHASE 0
#endif
namespace pg8 {
#define PG8_LAS __attribute__((address_space(3)))
typedef unsigned short bf16_t;
typedef short bf16x8 __attribute__((ext_vector_type(8)));
typedef float f32x4 __attribute__((ext_vector_type(4)));
typedef unsigned u32x4 __attribute__((ext_vector_type(4)));
constexpr int BM = 256, BK = 64, HALF = 128, HTB = HALF * BK * 2  , STAGE_BYTES = 8 * HTB, NXCD = 8, WGM = 4;

__host__ __device__ __forceinline__ int lds_byte(int r, int c) { const int st = (r >> 4) * 2 + (c >> 5), rr = r & 15, cc = c & 31, ob = rr * 64 + cc * 2; return st * 1024 + (ob ^ (((ob >> 9) & 1) << 5)); }
__host__ __device__ __forceinline__ void stage_rc(int b, int& R, int& C) { const int st = b / 1024, sb = b % 1024, swz = sb ^ (((sb >> 9) & 1) << 5); R = (st >> 1) * 16 + swz / 64; C = (st & 1) * 32 + (swz % 64) / 2; }
__host__ __device__ __forceinline__ int perm32(int rho) { const int n = rho >> 4, i = rho & 15; return 8 * (i >> 2) + 4 * n + (i & 3); }

struct Unit { int pm, pn, ko, ks, nkt; };
struct Gemm { const bf16_t* A; const bf16_t* Bt; int M, N, K, ld; };

struct StaticOrder {
    int nM, nN, nwg, G, c, nkt, bmode;
    __host__ __device__ void init(int M, int N, int G_, int c_, int nkt_) { nM = M / BM; nN = N / BM; nwg = nM * nN; G = G_; c = c_; nkt = nkt_; bmode = 0; }
    __host__ __device__ bool next(int i, Unit& u) const {
        const long L = (long)i * G + c; if (L >= nwg) return false;
        if (bmode) { const int x = (int)(L % NXCD), l = (int)(L / NXCD), per = nM / NXCD, nig = WGM * nN, fm = (l / nig) * WGM, gsz = (per - fm) < WGM ? (per - fm) : WGM;
            const int j = fm + (l % nig) % gsz; u.pn = (l % nig) / gsz;
            if (bmode == 1 && nN == 12 && fm == 0) u.pn = (u.pn + 8) % 12;
            u.pm = bmode == 1 ? (j < per - 1 ? (per - 1) * x + j : (nM - NXCD) + x) : per * x + j; u.ko = 0; u.ks = -1; u.nkt = nkt; return true; }
        int wgid = (int)L; { const int q = nwg / NXCD, r = nwg % NXCD, xcd = wgid % NXCD, off = wgid / NXCD; wgid = (xcd < r ? xcd * (q + 1) : r * (q + 1) + (xcd - r) * q) + off; }
        const int nig = WGM * nN, gid = wgid / nig, fm = gid * WGM, gsz = (nM - fm) < WGM ? (nM - fm) : WGM;
        u.pm = fm + ((wgid % nig) % gsz); u.pn = (wgid % nig) / gsz; u.ko = 0; u.ks = -1; u.nkt = nkt; return true;
    }
    __device__ __forceinline__ void a_ready(const Unit&) const {}
    __device__ __forceinline__ void done(const Unit&) const {}
};

struct SplitKOrder {
    int pm0, npm, nN, nks, kslice, G, c;
    __host__ __device__ void init(int pm0_, int npm_, int nN_, int nks_, int kslice_, int G_, int c_) { pm0 = pm0_; npm = npm_; nN = nN_; nks = nks_; kslice = kslice_; G = G_; c = c_; }
    __host__ __device__ bool next(int i, Unit& u) const {
        const long L = (long)i * G + c; if (L >= (long)npm * nN * nks) return false;
        const int l = (int)L, ks = l / (npm * nN), t = l % (npm * nN);
        u.pn = t / npm; u.pm = pm0 + t % npm; u.ks = ks; u.ko = ks * kslice; u.nkt = kslice / BK; return true;
    }
    __device__ __forceinline__ void a_ready(const Unit&) const {}
    __device__ __forceinline__ void done(const Unit&) const {}
};
struct ComboOrder {
    StaticOrder s; SplitKOrder k; int rs;
    __host__ __device__ void init(const StaticOrder& s_, const SplitKOrder& k_) { s = s_; k = k_; rs = (s.nwg + s.G - 1) / s.G; }
    __host__ __device__ bool next(int i, Unit& u) const { if (i < rs) return s.next(i, u); return k.next(i - rs, u); }
    __device__ __forceinline__ void a_ready(const Unit&) const {}
    __device__ __forceinline__ void done(const Unit&) const {}
};
__device__ __forceinline__ unsigned cvt_pk_bf16(float lo, float hi) { unsigned r; asm volatile("v_cvt_pk_bf16_f32 %0, %1, %2" : "=v"(r) : "v"(lo), "v"(hi)); return r; }
__device__ __forceinline__ void st16_wt(void* p, u32x4 v) { asm volatile("global_store_dwordx4 %0, %1, off sc1\n\ts_nop 1" :: "v"(p), "v"(v) : "memory"); }
template <int ACT> struct EpiStore {
    static constexpr bool PERM = true, AFTER_DRAIN = false;
    bf16_t* O; int ldc; bf16_t* Os; size_t slab; int row_sub;
    __device__ __forceinline__ void operator()(const f32x4 (&acc)[2][2][4][2], const Unit& u, int wr, int wc, int fr, int fq) const {
        const int row0 = u.pm * BM + wr * 64 + fr - (u.ks < 0 ? 0 : row_sub); const int col0 = u.pn * BM + wc * 32 + 8 * fq; bf16_t* Ob = u.ks < 0 ? O : Os + (size_t)u.ks * slab;
#pragma unroll
        for (int ai = 0; ai < 2; ++ai)
#pragma unroll
            for (int m = 0; m < 4; ++m) { bf16_t* rowp = Ob + (size_t)(row0 + ai * HALF + m * 16) * ldc + col0;
#pragma unroll
                for (int bj = 0; bj < 2; ++bj) { f32x4 v0 = acc[ai][bj][m][0], v1 = acc[ai][bj][m][1];
                    if (ACT == 2) {
#pragma unroll
                        for (int e = 0; e < 4; ++e) { float a = v0[e] > 0.f ? v0[e] : 0.f; v0[e] = a * a; float b = v1[e] > 0.f ? v1[e] : 0.f; v1[e] = b * b; } }
                    u32x4 w; w.x = cvt_pk_bf16(v0[0], v0[1]); w.y = cvt_pk_bf16(v0[2], v0[3]); w.z = cvt_pk_bf16(v1[0], v1[1]); w.w = cvt_pk_bf16(v1[2], v1[3]);
                    st16_wt(rowp + bj * HALF, w); } }
    }
};
template <class Epi, class Sched, bool ALIGN_EPI = false, bool SP2 = false>
__device__ __forceinline__ void gemm_phase(PG8_LAS unsigned char* lds, const Gemm g, const Sched& S, const Epi& E) {
    const int tid = threadIdx.x, wid = __builtin_amdgcn_readfirstlane(tid >> 6), lane = tid & 63, wr = wid >> 2, wc = wid & 3, fr = lane & 15, fq = lane >> 4;
    const int K = g.ld;
    unsigned voffA[2], voffB[2];
#pragma unroll
    for (int i = 0; i < 2; ++i) { int R, C; stage_rc(tid * 16 + i * 8192, R, C); const int Rb = Epi::PERM ? ((R & ~31) + perm32(R & 31)) : R;
        voffA[i] = (unsigned)(R * K + C) * 2u; voffB[i] = (unsigned)(Rb * K + C) * 2u; }
    const size_t kstep = (size_t)(BK * 2);
    const size_t hstep = (size_t)HALF * K * 2;
    const size_t tstep = 2 * hstep;
    const unsigned ldsw = (unsigned)wid * 1024u;
    const int aoff = lds_byte(wr * 64 + fr, fq * 8), boff = lds_byte(wc * 32 + fr, fq * 8);
#define PG8_SA(b, h) (((b) * 2 + (h)) * HTB)
#define PG8_SB(b, h) ((4 + (b) * 2 + (h)) * HTB)
#define PG8_STAGE(bufoff, gbase, voff) do { _Pragma("unroll") for (int _i = 0; _i < 2; ++_i) \
        __builtin_amdgcn_global_load_lds((const unsigned*)((const char*)(gbase) + (voff)[_i]), (PG8_LAS unsigned*)(lds + (bufoff) + ldsw + _i * 8192), 16, 0, 0); } while (0)
#define PG8_LDA(dst, b, h) do { _Pragma("unroll") for (int m = 0; m < 4; ++m) _Pragma("unroll") for (int k = 0; k < 2; ++k) dst[m][k] = *(const PG8_LAS bf16x8*)(lds + PG8_SA(b, h) + aoff + m * 2048 + k * 1024); } while (0)
#define PG8_LDB(dst, b, h) do { _Pragma("unroll") for (int n = 0; n < 2; ++n) _Pragma("unroll") for (int k = 0; k < 2; ++k) dst[n][k] = *(const PG8_LAS bf16x8*)(lds + PG8_SB(b, h) + boff + n * 2048 + k * 1024); } while (0)
#define PG8_MMA(ai, bj, At, Bt) do { __builtin_amdgcn_s_setprio(1); _Pragma("unroll") for (int m = 0; m < 4; ++m) _Pragma("unroll") for (int n = 0; n < 2; ++n) _Pragma("unroll") for (int k = 0; k < 2; ++k) \
        acc[ai][bj][m][n] = __builtin_amdgcn_mfma_f32_16x16x32_bf16(Bt[n][k], At[m][k], acc[ai][bj][m][n], 0, 0, 0); __builtin_amdgcn_s_setprio(0); } while (0)
#define PG8_WAIT_V(n) asm volatile("s_waitcnt vmcnt(" #n ")" ::: "memory")
#define PG8_WAIT_L(n) asm volatile("s_waitcnt lgkmcnt(" #n ")" ::: "memory")
#define PG8_BAR __builtin_amdgcn_s_barrier()
#define PG8_SCHED __builtin_amdgcn_sched_barrier(0)
    Unit cur, nxt; int ui = 0;
    if (!S.next(0, cur)) return;
    f32x4 acc[2][2][4][2];
#pragma unroll
    for (int a = 0; a < 2; ++a)
#pragma unroll
        for (int b = 0; b < 2; ++b)
#pragma unroll
            for (int m = 0; m < 4; ++m)
#pragma unroll
                for (int n = 0; n < 2; ++n) acc[a][b][m][n] = (f32x4){0.f, 0.f, 0.f, 0.f};
    bf16x8 At[4][2], B0[2][2], B1[2][2];
    const char* cA = (const char*)g.A + (size_t)cur.pm * tstep + (size_t)cur.ko * 2; const char* cB = (const char*)g.Bt + (size_t)cur.pn * tstep + (size_t)cur.ko * 2;
    S.a_ready(cur);
    if constexpr (SP2) {
        PG8_STAGE(PG8_SB(0, 0), cB, voffB); PG8_STAGE(PG8_SB(0, 1), cB + hstep, voffB); PG8_STAGE(PG8_SA(0, 0), cA, voffA); PG8_STAGE(PG8_SA(0, 1), cA + hstep, voffA);
        if (wr == 1) PG8_BAR;
        PG8_WAIT_V(2); PG8_BAR;
        PG8_STAGE(PG8_SB(1, 0), cB + kstep, voffB); PG8_STAGE(PG8_SA(1, 0), cA + kstep, voffA); PG8_STAGE(PG8_SB(1, 1), cB + hstep + kstep, voffB);
        PG8_WAIT_V(6); PG8_BAR;
    } else {
        PG8_STAGE(PG8_SB(0, 0), cB, voffB); PG8_STAGE(PG8_SA(0, 0), cA, voffA); PG8_STAGE(PG8_SB(0, 1), cB + hstep, voffB); PG8_STAGE(PG8_SA(0, 1), cA + hstep, voffA);
        if (wr == 1) PG8_BAR;
        PG8_WAIT_V(4); PG8_BAR;
        PG8_STAGE(PG8_SB(1, 0), cB + kstep, voffB); PG8_STAGE(PG8_SA(1, 0), cA + kstep, voffA); PG8_STAGE(PG8_SB(1, 1), cB + hstep + kstep, voffB);
        PG8_WAIT_V(6); PG8_BAR;
    }
    for (;;) {
        const bool has_next = S.next(ui + 1, nxt); const int nt = cur.nkt;
        const char* nA = has_next ? (const char*)g.A + (size_t)nxt.pm * tstep + (size_t)nxt.ko * 2 : cA; const char* nB = has_next ? (const char*)g.Bt + (size_t)nxt.pn * tstep + (size_t)nxt.ko * 2 : cB;
        for (int t = 0; t < nt; t += 2) {
            const bool last = (t == nt - 2);
            const char* a1 = cA + (size_t)(t + 1) * kstep;
            const char* a2 = last ? nA : cA + (size_t)(t + 2) * kstep; const char* b2 = last ? nB : cB + (size_t)(t + 2) * kstep;
            const char* a3 = a2 + kstep; const char* b3 = b2 + kstep;
            if (last && has_next) S.a_ready(nxt);
            if constexpr (SP2) {
            PG8_LDB(B0, 0, 0); PG8_LDB(B1, 0, 1); PG8_SCHED; PG8_LDA(At, 0, 0); PG8_STAGE(PG8_SA(1, 1), a1 + hstep, voffA);
            PG8_WAIT_V(8); PG8_WAIT_L(0); PG8_BAR; PG8_MMA(0, 0, At, B0); PG8_MMA(0, 1, At, B1); PG8_BAR; PG8_SCHED;
            PG8_LDA(At, 0, 1); PG8_STAGE(PG8_SB(0, 0), b2, voffB); PG8_STAGE(PG8_SB(0, 1), b2 + hstep, voffB); PG8_STAGE(PG8_SA(0, 0), a2, voffA);
            PG8_WAIT_V(8); PG8_WAIT_L(0); PG8_BAR; PG8_MMA(1, 0, At, B0); PG8_MMA(1, 1, At, B1); PG8_BAR; PG8_SCHED;
            PG8_LDB(B0, 1, 0); PG8_LDB(B1, 1, 1); PG8_SCHED; PG8_LDA(At, 1, 0); PG8_STAGE(PG8_SA(0, 1), a2 + hstep, voffA);
            PG8_WAIT_V(8); PG8_WAIT_L(0); PG8_BAR; PG8_MMA(0, 0, At, B0); PG8_MMA(0, 1, At, B1); PG8_BAR; PG8_SCHED;
            PG8_LDA(At, 1, 1); PG8_STAGE(PG8_SB(1, 0), b3, voffB); PG8_STAGE(PG8_SB(1, 1), b3 + hstep, voffB); PG8_STAGE(PG8_SA(1, 0), a3, voffA);
            PG8_WAIT_V(8); PG8_WAIT_L(0); PG8_BAR; PG8_MMA(1, 0, At, B0); PG8_MMA(1, 1, At, B1); PG8_BAR; PG8_SCHED;
            } else {
            PG8_LDB(B0, 0, 0); PG8_SCHED; PG8_LDA(At, 0, 0); PG8_STAGE(PG8_SA(1, 1), a1 + hstep, voffA);
            PG8_WAIT_L(8); PG8_BAR; PG8_WAIT_L(0); PG8_MMA(0, 0, At, B0); PG8_BAR; PG8_SCHED;
            PG8_LDB(B1, 0, 1); PG8_STAGE(PG8_SB(0, 0), b2, voffB);
            PG8_BAR; PG8_WAIT_L(0); PG8_MMA(0, 1, At, B1); PG8_BAR;
            PG8_LDA(At, 0, 1); PG8_STAGE(PG8_SA(0, 0), a2, voffA);
            PG8_BAR; PG8_WAIT_L(0); PG8_MMA(1, 0, At, B0); PG8_BAR; PG8_SCHED;
            PG8_STAGE(PG8_SB(0, 1), b2 + hstep, voffB);
            PG8_WAIT_V(6); PG8_BAR; PG8_MMA(1, 1, At, B1); PG8_BAR;
            PG8_LDB(B0, 1, 0); PG8_SCHED; PG8_LDA(At, 1, 0); PG8_STAGE(PG8_SA(0, 1), a2 + hstep, voffA);
            PG8_WAIT_L(8); PG8_BAR; PG8_WAIT_L(0); PG8_MMA(0, 0, At, B0); PG8_BAR; PG8_SCHED;
            PG8_LDB(B1, 1, 1); PG8_STAGE(PG8_SB(1, 0), b3, voffB);
            PG8_BAR; PG8_WAIT_L(0); PG8_MMA(0, 1, At, B1); PG8_BAR;
            PG8_LDA(At, 1, 1); PG8_STAGE(PG8_SA(1, 0), a3, voffA);
            PG8_BAR; PG8_WAIT_L(0); PG8_MMA(1, 0, At, B0); PG8_BAR; PG8_SCHED;
            PG8_STAGE(PG8_SB(1, 1), b3 + hstep, voffB);
            PG8_WAIT_V(6); PG8_BAR; PG8_MMA(1, 1, At, B1); PG8_BAR;
            }
        }
        if constexpr (ALIGN_EPI) { if (wr == 0) PG8_BAR; }
        if constexpr (!Epi::AFTER_DRAIN) { E(acc, cur, wr, wc, fr, fq); S.done(cur); }
        if (!has_next) break;
#pragma unroll
        for (int a = 0; a < 2; ++a)
#pragma unroll
            for (int b = 0; b < 2; ++b)
#pragma unroll
                for (int m = 0; m < 4; ++m)
#pragma unroll
                    for (int n = 0; n < 2; ++n) acc[a][b][m][n] = (f32x4){0.f, 0.f, 0.f, 0.f};
        cur = nxt; cA = nA; cB = nB; ++ui;
        if constexpr (ALIGN_EPI) { if (wr == 1) PG8_BAR; }
    }
    PG8_WAIT_V(0);
    if constexpr (!ALIGN_EPI) { if (wr == 0) PG8_BAR; }
    PG8_BAR;
    if constexpr (Epi::AFTER_DRAIN) { E.fused(acc, cur, wr, wc, fr, fq, lds, wid, lane); S.done(cur); }
#undef PG8_SA
#undef PG8_SB
#undef PG8_STAGE
#undef PG8_LDA
#undef PG8_LDB
#undef PG8_MMA
#undef PG8_WAIT_V
#undef PG8_WAIT_L
#undef PG8_BAR
#undef PG8_SCHED
}
}
constexpr int NWAVES = 8;
#ifndef MK_PER_PHASE
#define MK_PER_PHASE 0
#endif
constexpr int N_PHASES = 20;

constexpr int NBATCH = 8, SEQ = 2048, LCTX = 256, DM = 1024, MLAT = NBATCH * SEQ, MCTX = NBATCH * LCTX, MALL = MLAT + MCTX;
constexpr int NPROJ = 3072, DIN = 2956, DFF = 4096;
constexpr int C_QA = 0, C_KA = 384, C_VA = 512, C_QR = 640, C_KR = 896, C_VR = 1152, C_GR = 1408, C_Z = 1664, C_XBC = 2048, C_DT = 2944;
constexpr int XBW = 896;
constexpr float EPS = 1e-6f;
constexpr float QSCALE = 0.125f * 1.4426950408889634f;
constexpr float LOG2E = 1.4426950408889634f;

constexpr size_t MiB = 1u << 20;
constexpr size_t WS_CTL = 0, CTL_ZERO_BYTES = 128 * 1024;
constexpr size_t WS_MOD = 1 * MiB;
constexpr size_t WS_WIN = 2 * MiB, WS_WOUT = 8 * MiB, WS_W1 = 10 * MiB, WS_W2 = 18 * MiB;
constexpr size_t WS_XN = 26 * MiB;
constexpr size_t WS_BIG = 62 * MiB;
constexpr size_t WS_XBC2 = 170 * MiB;
constexpr size_t WS_DTLA = 202 * MiB;
constexpr size_t WS_XC = 206 * MiB;
constexpr size_t WS_XB = 214 * MiB;
constexpr size_t WS_WIN1 = 246 * MiB;
constexpr size_t WS_END = 256 * MiB;
static_assert(WS_XB + (size_t)MLAT * DM * 2 <= WS_WIN1 && WS_WIN1 + (size_t)NPROJ * DM * 2 <= WS_END, "ws map 3");
static_assert(WS_BIG + (size_t)MALL * NPROJ * 2 <= WS_XBC2 && WS_XBC2 + (size_t)MALL * XBW * 2 <= WS_DTLA && WS_DTLA + (size_t)MALL * 24 * 4 <= WS_XC, "ws map 1");
static_assert(WS_BIG + (size_t)MALL * DFF * 2 <= WS_XC && WS_XB + (size_t)MLAT * DM * 2 <= WS_END && WS_XN + (size_t)MALL * DM * 2 <= WS_BIG, "ws map 2");
constexpr int CW_TMO = 0, CW_CODE = 1, CW_BAR = 4096, CW_QUEUE = 16384, CW_FLAGS = 20480;

constexpr int RING_OFF = 0, RING_BYTES = 131072;
constexpr int LDS_BYTES = 147456;
constexpr int LDSCTL_OFF = LDS_BYTES - 512, MISC_OFF = LDSCTL_OFF + 320;

#define GAS __attribute__((address_space(1)))
#define LAS __attribute__((address_space(3)))
typedef unsigned short bf16;
typedef unsigned v4u __attribute__((ext_vector_type(4)));
typedef unsigned v2u __attribute__((ext_vector_type(2)));
typedef float f32x4 __attribute__((ext_vector_type(4)));
typedef float f32x2 __attribute__((ext_vector_type(2)));
typedef float f32x16 __attribute__((ext_vector_type(16)));
typedef short bf16x8 __attribute__((ext_vector_type(8)));
typedef short s16x4 __attribute__((ext_vector_type(4)));
typedef __bf16 bf16x2_t __attribute__((ext_vector_type(2)));
typedef GAS unsigned gu32;
#define RLX_AGENT __ATOMIC_RELAXED, __HIP_MEMORY_SCOPE_AGENT
#define LDS_WAIT() asm volatile("s_waitcnt lgkmcnt(0)" ::: "memory")
#define VM_WAIT() asm volatile("s_waitcnt vmcnt(0)" ::: "memory")
__device__ __forceinline__ unsigned f2bf(float f) { unsigned u = __builtin_bit_cast(unsigned, f); return (u + 0x7fffu + ((u >> 16) & 1u)) >> 16; }
__device__ __forceinline__ unsigned pk2(float lo, float hi) { f32x2 v = {lo, hi}; bf16x2_t b = __builtin_convertvector(v, bf16x2_t); return __builtin_bit_cast(unsigned, b); }
__device__ __forceinline__ float bflo(unsigned u) { return __builtin_bit_cast(float, u << 16); }
__device__ __forceinline__ float bfhi(unsigned u) { return __builtin_bit_cast(float, u & 0xffff0000u); }
__device__ __forceinline__ float bf1(bf16 h) { return __builtin_bit_cast(float, (unsigned)h << 16); }
__device__ __forceinline__ float silu_f(float x) { return x / (1.f + expf(-x)); }
__device__ __forceinline__ float wave_sum(float v) {
#pragma unroll
    for (int o = 1; o < 64; o <<= 1) v += __shfl_xor(v, o);
    return v;
}
__device__ __forceinline__ float sum16(float v) {
    v += __shfl_xor(v, 1); v += __shfl_xor(v, 2); v += __shfl_xor(v, 4); v += __shfl_xor(v, 8); return v;
}
typedef short v4i16_t __attribute__((ext_vector_type(4)));
__device__ __forceinline__ s16x4 tr16(const LAS unsigned char* p) { return __builtin_bit_cast(s16x4, __builtin_amdgcn_ds_read_tr16_b64_v4i16((LAS v4i16_t*)p)); }
__device__ __forceinline__ void st16_wt(const void* p, v4u v) { asm volatile("global_store_dwordx4 %0, %1, off sc1\n\ts_nop 1" :: "v"(p), "v"(v) : "memory"); }
__device__ __forceinline__ void st8_wt(const void* p, v2u v) { asm volatile("global_store_dwordx2 %0, %1, off sc1\n\ts_nop 0" :: "v"(p), "v"(v) : "memory"); }
__device__ __forceinline__ float max3f(float a, float b, float c) { float r; asm("v_max3_f32 %0, %1, %2, %3" : "=v"(r) : "v"(a), "v"(b), "v"(c)); return r; }
#define CAT8(lo, hi) __builtin_shufflevector(lo, hi, 0, 1, 2, 3, 4, 5, 6, 7)
#define MFMA16(a, b, c) __builtin_amdgcn_mfma_f32_16x16x32_bf16((a), (b), (c), 0, 0, 0)
#define MFMA32(a, b, c) __builtin_amdgcn_mfma_f32_32x32x16_bf16((a), (b), (c), 0, 0, 0)

#define XB_TMO      128
#define XB_XCNT(j)  (256  + 64 * (j))
#define XB_XSUB(j)  (1280 + 64 * (j))
#define XB_XGEN(j)  (2304 + 64 * (j))
#define XB_TOP      3328
#define XB_TOPGEN   3392
#define XCD_BAR_WORDS 3456
#define XB_SPIN_CAP (1u << 18)

__device__ __forceinline__ unsigned xb_ld(unsigned* p)              { return __hip_atomic_load(p, __ATOMIC_RELAXED, __HIP_MEMORY_SCOPE_AGENT); }
__device__ __forceinline__ unsigned xb_add(unsigned* p, unsigned v) { return __hip_atomic_fetch_add(p, v, __ATOMIC_RELAXED, __HIP_MEMORY_SCOPE_AGENT); }
__device__ __forceinline__ unsigned xb_xcc_id() { return (unsigned)__builtin_amdgcn_s_getreg((3 << 11) | 20) & 0xFu; }
#define XB_SPIN(cond, bar) do { unsigned _sp = 0; while (cond) { __builtin_amdgcn_s_sleep(1); \
    if ((++_sp & 255u) == 0u) { if (xb_ld(&(bar)[XB_TMO])) break; if (_sp > XB_SPIN_CAP) { atomicAdd(&(bar)[XB_TMO], 1u); break; } } } } while (0)

struct XcdBarrier {
    unsigned* bar; unsigned x;
    volatile LAS unsigned* st;
};

__device__ __forceinline__ XcdBarrier xcd_barrier_post(unsigned* bar, volatile LAS unsigned* st) {
    XcdBarrier b; b.bar = bar; b.x = xb_xcc_id(); b.st = st;
    if (threadIdx.x == 0) (void)xb_add(&bar[XB_XCNT(b.x)], 1u);
    return b;
}
__device__ __forceinline__ void xcd_barrier_complete(unsigned* bar, unsigned x, unsigned& nloc, unsigned& nx) {
    const unsigned G = gridDim.x * gridDim.y * gridDim.z;
    unsigned sum, cnt, mine, sp = 0u;
    for (;;) {
        sum = 0u; cnt = 0u; mine = 0u;
#pragma unroll
        for (unsigned j = 0; j < 16; ++j) { const unsigned c = xb_ld(&bar[XB_XCNT(j)]); sum += c; cnt += (c > 0u) ? 1u : 0u; mine = (j == x) ? c : mine; }
        if (sum == G) break;
        __builtin_amdgcn_s_sleep(1);
        if ((++sp & 255u) == 0u) { if (xb_ld(&bar[XB_TMO])) break; if (sp > XB_SPIN_CAP) { atomicAdd(&bar[XB_TMO], 1u); break; } }
    }
    nloc = mine > 0u ? mine : 1u; nx = cnt > 0u ? cnt : 1u;
}

__device__ __forceinline__ void xcd_barrier(const XcdBarrier& b, const bool light = false) {
    asm volatile("s_waitcnt vmcnt(0)" ::: "memory");
    __syncthreads();
    if (threadIdx.x == 0) {
        unsigned* bar = b.bar;
        __builtin_amdgcn_s_waitcnt(0);
        unsigned nloc = b.st[0], nx = b.st[1];
        if (nloc == 0u) { xcd_barrier_complete(bar, b.x, nloc, nx); b.st[0] = nloc; b.st[1] = nx; }
        const unsigned old = xb_add(&bar[XB_XSUB(b.x)], 1u);
        const unsigned gen = old / nloc;
        if (old + 1u == (gen + 1u) * nloc) {
            if (!light) __builtin_amdgcn_fence(__ATOMIC_RELEASE, "agent");
            asm volatile("s_waitcnt vmcnt(0)" ::: "memory");
            const unsigned og = xb_add(&bar[XB_TOP], 1u);
            const unsigned tg = og / nx;
            if (og + 1u == (tg + 1u) * nx) xb_add(&bar[XB_TOPGEN], 1u);
            else XB_SPIN(xb_ld(&bar[XB_TOPGEN]) == tg, bar);
            __builtin_amdgcn_fence(__ATOMIC_ACQUIRE, "agent");
            xb_add(&bar[XB_XGEN(b.x)], 1u);
            asm volatile("s_waitcnt vmcnt(0)" ::: "memory");
        } else {
            XB_SPIN(xb_ld(&bar[XB_XGEN(b.x)]) == gen, bar);
            __builtin_amdgcn_fence(__ATOMIC_ACQUIRE, "agent");
            asm volatile("s_waitcnt vmcnt(0)" ::: "memory");
        }
    }
    __syncthreads();
}
struct Frame {
    LAS unsigned char* lds;
    volatile LAS unsigned* MISC;
    gu32* ctl;
    int tid, lane, wave;
    int vcu, G;
};
struct Args { const float* in[22]; float* out; unsigned char* ws; int ph_lo, ph_hi, li, pad; };

__host__ __device__ __forceinline__ int proj_natural(int pos) {
    if (pos >= 1152) return pos;
    if (pos >= 1024) return pos - 512;
    const int tile = pos >> 8, bj = (pos >> 7) & 1, wc = (pos >> 5) & 3, dim = 32 * bj + (pos & 31);
    const int base = tile == 0 ? wc * 64 : tile == 1 ? (wc < 2 ? (4 + wc) * 64 : C_KA + (wc - 2) * 64) : tile == 2 ? C_QR + wc * 64 : C_KR + wc * 64;
    return base + dim;
}
__device__ __forceinline__ void transpose_item(const float* W, int K, int Nreal, int nblk, bf16* WT, LAS float* scr, int item, int lane, bool permw = false) {
    const int kb = item / nblk, nb = item % nblk, k0 = 64 * kb, n0 = 32 * nb;
    const int nn = (permw ? proj_natural(n0) : n0) + (lane & 31); const bool okn = nn < Nreal; const int nnc = okn ? nn : Nreal - 1;
    float wv[32];
#pragma unroll
    for (int i = 0; i < 32; ++i) { const int kk = 2 * i + (lane >> 5); wv[i] = __builtin_nontemporal_load((const GAS float*)W + (size_t)(k0 + kk) * Nreal + nnc); }
#pragma unroll
    for (int i = 0; i < 32; ++i) { const int kk = 2 * i + (lane >> 5); scr[kk * 33 + (lane & 31)] = okn ? wv[i] : 0.f; }
    LDS_WAIT(); asm volatile("" ::: "memory");
    const int c = lane & 7;
#pragma unroll
    for (int j = 0; j < 4; ++j) { const int n = (lane >> 3) + 8 * j; const LAS float* s = scr + (8 * c) * 33 + n;
        v4u o; o.x = pk2(s[0 * 33], s[1 * 33]); o.y = pk2(s[2 * 33], s[3 * 33]); o.z = pk2(s[4 * 33], s[5 * 33]); o.w = pk2(s[6 * 33], s[7 * 33]);
        *(GAS v4u*)(WT + (size_t)(n0 + n) * K + k0 + 8 * c) = o; }
    LDS_WAIT(); asm volatile("" ::: "memory");
}
__device__ __forceinline__ void convert_weights(Frame& F, const Args& A, int layer, int part) {
    LAS float* scr = (LAS float*)(F.lds + RING_OFF + F.wave * 16384);
    const int gw = F.vcu * NWAVES + F.wave, NGW = F.G * NWAVES;
    const float* Win = A.in[7] + (size_t)layer * DM * DIN; const float* Wout = A.in[8] + (size_t)layer * DM * DM;
    const float* W1 = A.in[20] + (size_t)layer * DM * DFF; const float* W2 = A.in[21] + (size_t)layer * DFF * DM;
    bf16* Win_t = (bf16*)(A.ws + WS_WIN); bf16* Wout_t = (bf16*)(A.ws + WS_WOUT); bf16* W1_t = (bf16*)(A.ws + WS_W1); bf16* W2_t = (bf16*)(A.ws + WS_W2);
    constexpr int I_IN = (DM / 64) * (NPROJ / 32), I_OUT = (DM / 64) * (DM / 32), I_1 = (DM / 64) * (DFF / 32), I_2 = (DFF / 64) * (DM / 32);
    if (part == 0) { for (int it = gw; it < I_IN; it += NGW) transpose_item(Win, DM, DIN, NPROJ / 32, Win_t, scr, it, F.lane, true); return; }
    if (part == 2) {
        const int h0 = (MALL / 256) * (NPROJ / 256) - 3 * F.G; const int w0 = (h0 > 0 && h0 < F.G) ? h0 : 0; if ((int)blockIdx.x < w0) return;
        bf16* Win1_t = (bf16*)(A.ws + WS_WIN1);
        for (int it = ((int)blockIdx.x - w0) * NWAVES + F.wave; it < I_IN; it += (F.G - w0) * NWAVES) transpose_item(Win, DM, DIN, NPROJ / 32, Win1_t, scr, it, F.lane, true);
        return; }
    const int idle0 = (MALL / 256) * (NPROJ / 256) - 3 * F.G;
    const int w0 = (idle0 > 0 && idle0 < F.G) ? idle0 : 0; if ((int)blockIdx.x < w0) return;
    for (int it = ((int)blockIdx.x - w0) * NWAVES + F.wave; it < I_OUT + I_1 + I_2; it += (F.G - w0) * NWAVES) {
        int r = it;
        if (r < I_OUT) { transpose_item(Wout, DM, DM, DM / 32, Wout_t, scr, r, F.lane); continue; } r -= I_OUT;
        if (r < I_1) { transpose_item(W1, DM, DFF, DFF / 32, W1_t, scr, r, F.lane); continue; } r -= I_1;
        transpose_item(W2, DFF, DM, DM / 32, W2_t, scr, r, F.lane);
    }
}
__device__ __forceinline__ void mod_phase(Frame& F, const Args& A) {
    LAS float* sact = (LAS float*)(F.lds + RING_OFF);
    LAS float* red = (LAS float*)(F.lds + RING_OFF + 36864);
    float* MOD = (float*)(A.ws + WS_MOD);
    bool have = false;
    for (int unit = F.vcu; unit < 2 * 96; unit += F.G) {
        if (!have) {
            for (int i = F.tid; i < 9 * 1024; i += NWAVES * 64) { const int r = i >> 10, k = i & 1023; const float v = r < 8 ? A.in[1][r * DM + k] : A.in[3][k]; sact[i] = silu_f(v); }
            __syncthreads(); have = true;
        }
        const int layer = unit / 96, cb = unit % 96;
        const float* W = A.in[4] + (size_t)layer * DM * 6144 + cb * 64 + F.lane;
        float acc[9];
#pragma unroll
        for (int r = 0; r < 9; ++r) acc[r] = 0.f;
        for (int kk0 = 0; kk0 < 128; kk0 += 43) { float wv[43];
#pragma unroll
            for (int j = 0; j < 43; ++j) { const int kr = kk0 + j < 128 ? kk0 + j : 127; wv[j] = __builtin_nontemporal_load((const GAS float*)W + (size_t)(F.wave * 128 + kr) * 6144); }
#pragma unroll
            for (int j = 0; j < 43; ++j) { const int k = F.wave * 128 + (kk0 + j < 128 ? kk0 + j : 127); const float wj = kk0 + j < 128 ? wv[j] : 0.f;
#pragma unroll
                for (int r = 0; r < 9; ++r) acc[r] += sact[r * 1024 + k] * wj; } }
#pragma unroll
        for (int r = 0; r < 9; ++r) red[(F.wave * 9 + r) * 64 + F.lane] = acc[r];
        __syncthreads();
        for (int i = F.tid; i < 576; i += NWAVES * 64) { const int r = i >> 6, l = i & 63; float s = 0.f;
#pragma unroll
            for (int w = 0; w < 8; ++w) s += red[(w * 9 + r) * 64 + l];
            MOD[(size_t)(layer * 9 + r) * 6144 + cb * 64 + l] = s + A.in[5][layer * 6144 + cb * 64 + l]; }
        __syncthreads();
    }
    __syncthreads();
}

__device__ __forceinline__ v2u ld8_sc1(const v2u* p) { const unsigned long long x = __hip_atomic_load((const GAS unsigned long long*)p, __ATOMIC_RELAXED, __HIP_MEMORY_SCOPE_AGENT); v2u r; r.x = (unsigned)x; r.y = (unsigned)(x >> 32); return r; }
struct RowPass {
    const void* xs_lat; const float* xs_ctx; const bf16* o; void* xd_lat; float* xd_ctx; bf16* xn;
    const float* gate; const float* ngo; const float* ngx; const float* scale; const float* shift; int M; const bf16* oslab;
};
__device__ __forceinline__ f32x4 bf4(v2u w) { return (f32x4){bflo(w.x), bfhi(w.x), bflo(w.y), bfhi(w.y)}; }
template <int NR, int XS, int XD, int NSLAB = 8>
__device__ __forceinline__ void row_pass_rows(const RowPass& P, const int (&mr)[NR], int lane) {
    f32x4 v[NR][4], ov[NR][4]; int mrow[NR]; bool lat[NR];
#pragma unroll
    for (int q = 0; q < NR; ++q) { const int m = mr[q]; lat[q] = m < MLAT; mrow[q] = lat[q] ? (m >> 11) : 8;
        if (XS == 1 && lat[q]) { const v2u* xr = (const v2u*)((const bf16*)P.xs_lat + (size_t)m * DM);
#pragma unroll
            for (int j = 0; j < 4; ++j) v[q][j] = bf4(__builtin_nontemporal_load(xr + lane + 64 * j));
        } else { const float* xr = lat[q] ? (const float*)P.xs_lat + (size_t)m * DM : P.xs_ctx + (size_t)(m - MLAT) * DM;
#pragma unroll
            for (int j = 0; j < 4; ++j) v[q][j] = __builtin_nontemporal_load((const f32x4*)xr + lane + 64 * j); } }
    if (P.o) {
#pragma unroll
        for (int q = 0; q < NR; ++q) { const int m = mr[q];
            if (!lat[q] && P.oslab) {
#pragma unroll
                for (int j = 0; j < 4; ++j) ov[q][j] = (f32x4){0.f, 0.f, 0.f, 0.f};
                v2u sw[NSLAB][4];
#pragma unroll
                for (int ks = 0; ks < NSLAB; ++ks) { const v2u* orow = (const v2u*)(P.oslab + ((size_t)ks * MCTX + (m - MLAT)) * DM);
#pragma unroll
                    for (int j = 0; j < 4; ++j) sw[ks][j] = ld8_sc1(orow + lane + 64 * j); }
#pragma unroll
                for (int ks = 0; ks < NSLAB; ++ks)
#pragma unroll
                    for (int j = 0; j < 4; ++j) ov[q][j] = ov[q][j] + bf4(sw[ks][j]);
            } else { const v2u* orow = (const v2u*)(P.o + (size_t)m * DM);
#pragma unroll
                for (int j = 0; j < 4; ++j) { const v2u w = ld8_sc1(orow + lane + 64 * j); ov[q][j] = bf4(w); } } }
        float ss[NR];
#pragma unroll
        for (int q = 0; q < NR; ++q) { ss[q] = 0.f;
#pragma unroll
            for (int j = 0; j < 4; ++j) ss[q] += (ov[q][j].x * ov[q][j].x + ov[q][j].y * ov[q][j].y) + (ov[q][j].z * ov[q][j].z + ov[q][j].w * ov[q][j].w); }
#pragma unroll
        for (int o = 1; o < 64; o <<= 1) {
#pragma unroll
            for (int q = 0; q < NR; ++q) ss[q] += __shfl_xor(ss[q], o); }
#pragma unroll
        for (int q = 0; q < NR; ++q) { const float rstd = rsqrtf(ss[q] * (1.f / DM) + EPS);
#pragma unroll
            for (int j = 0; j < 4; ++j) { const f32x4 g4 = ((const f32x4*)(P.gate + (size_t)mrow[q] * 6144))[lane + 64 * j]; const f32x4 n4 = ((const f32x4*)P.ngo)[lane + 64 * j];
                v[q][j] = v[q][j] + g4 * ((ov[q][j] * rstd) * n4); } }
    }
#pragma unroll
    for (int q = 0; q < NR; ++q) { const int m = mr[q];
        if (lat[q]) {
            if (P.xd_lat) {
                if (XD == 1) { v2u* xd = (v2u*)((bf16*)P.xd_lat + (size_t)m * DM);
#pragma unroll
                    for (int j = 0; j < 4; ++j) { v2u w; w.x = pk2(v[q][j].x, v[q][j].y); w.y = pk2(v[q][j].z, v[q][j].w); __builtin_nontemporal_store(w, xd + lane + 64 * j); }
                } else { float* xd = (float*)P.xd_lat + (size_t)m * DM;
#pragma unroll
                    for (int j = 0; j < 4; ++j) __builtin_nontemporal_store(v[q][j], (f32x4*)xd + lane + 64 * j); } }
        } else if (P.xd_ctx) { float* xd = P.xd_ctx + (size_t)(m - MLAT) * DM;
#pragma unroll
            for (int j = 0; j < 4; ++j) __builtin_nontemporal_store(v[q][j], (f32x4*)xd + lane + 64 * j); } }
    if (P.xn) {
        float ss[NR];
#pragma unroll
        for (int q = 0; q < NR; ++q) { ss[q] = 0.f;
#pragma unroll
            for (int j = 0; j < 4; ++j) ss[q] += (v[q][j].x * v[q][j].x + v[q][j].y * v[q][j].y) + (v[q][j].z * v[q][j].z + v[q][j].w * v[q][j].w); }
#pragma unroll
        for (int o = 1; o < 64; o <<= 1) {
#pragma unroll
            for (int q = 0; q < NR; ++q) ss[q] += __shfl_xor(ss[q], o); }
#pragma unroll
        for (int q = 0; q < NR; ++q) { const float rstd = rsqrtf(ss[q] * (1.f / DM) + EPS); v2u* xo = (v2u*)(P.xn + (size_t)mr[q] * DM);
#pragma unroll
            for (int j = 0; j < 4; ++j) { const f32x4 n4 = ((const f32x4*)P.ngx)[lane + 64 * j]; const f32x4 sc = ((const f32x4*)(P.scale + (size_t)mrow[q] * 6144))[lane + 64 * j];
                const f32x4 sh = ((const f32x4*)(P.shift + (size_t)mrow[q] * 6144))[lane + 64 * j];
                const f32x4 y = ((v[q][j] * rstd) * n4) * (sc + 1.f) + sh; v2u w; w.x = pk2(y.x, y.y); w.y = pk2(y.z, y.w); xo[lane + 64 * j] = w; } }
    }
}
template <int XS> struct RowRaw;
template <> struct RowRaw<0> { f32x4 x[2][4]; v2u o[2][4]; };
template <> struct RowRaw<1> { v2u x[2][4]; v2u o[2][4]; };
template <int XS>
__device__ __forceinline__ void row_raw_load(const RowPass& P, RowRaw<XS>& R, int m0, int m1, int lane) {
    const int mr[2] = {m0, m1};
#pragma unroll
    for (int q = 0; q < 2; ++q) {
        if constexpr (XS == 1) { const v2u* xr = (const v2u*)((const bf16*)P.xs_lat + (size_t)mr[q] * DM);
#pragma unroll
            for (int j = 0; j < 4; ++j) R.x[q][j] = __builtin_nontemporal_load(xr + lane + 64 * j);
        } else { const float* xr = (const float*)P.xs_lat + (size_t)mr[q] * DM;
#pragma unroll
            for (int j = 0; j < 4; ++j) R.x[q][j] = __builtin_nontemporal_load((const f32x4*)xr + lane + 64 * j); }
        if (P.o) { const v2u* orow = (const v2u*)(P.o + (size_t)mr[q] * DM);
#pragma unroll
            for (int j = 0; j < 4; ++j) R.o[q][j] = ld8_sc1(orow + lane + 64 * j); } }
}
template <int XS, int XD>
__device__ __forceinline__ void row_raw_compute(const RowPass& P, const RowRaw<XS>& R, int m0, int m1, int lane) {
    const int mr[2] = {m0, m1}; f32x4 v[2][4];
#pragma unroll
    for (int q = 0; q < 2; ++q)
#pragma unroll
        for (int j = 0; j < 4; ++j) { if constexpr (XS == 1) v[q][j] = bf4(R.x[q][j]); else v[q][j] = R.x[q][j]; }
    if (P.o) {
        f32x4 ov[2][4]; float ss[2];
#pragma unroll
        for (int q = 0; q < 2; ++q) { ss[q] = 0.f;
#pragma unroll
            for (int j = 0; j < 4; ++j) { ov[q][j] = bf4(R.o[q][j]);
                ss[q] += (ov[q][j].x * ov[q][j].x + ov[q][j].y * ov[q][j].y) + (ov[q][j].z * ov[q][j].z + ov[q][j].w * ov[q][j].w); } }
#pragma unroll
        for (int o = 1; o < 64; o <<= 1) { ss[0] += __shfl_xor(ss[0], o); ss[1] += __shfl_xor(ss[1], o); }
#pragma unroll
        for (int q = 0; q < 2; ++q) { const float rstd = rsqrtf(ss[q] * (1.f / DM) + EPS); const int mrow = mr[q] >> 11;
#pragma unroll
            for (int j = 0; j < 4; ++j) { const f32x4 g4 = ((const f32x4*)(P.gate + (size_t)mrow * 6144))[lane + 64 * j]; const f32x4 n4 = ((const f32x4*)P.ngo)[lane + 64 * j];
                v[q][j] = v[q][j] + g4 * ((ov[q][j] * rstd) * n4); } }
    }
    if (P.xd_lat) {
#pragma unroll
        for (int q = 0; q < 2; ++q)
#pragma unroll
            for (int j = 0; j < 4; ++j) {
                if constexpr (XD == 1) { v2u w; w.x = pk2(v[q][j].x, v[q][j].y); w.y = pk2(v[q][j].z, v[q][j].w); __builtin_nontemporal_store(w, (v2u*)((bf16*)P.xd_lat + (size_t)mr[q] * DM) + lane + 64 * j); }
                else __builtin_nontemporal_store(v[q][j], (f32x4*)((float*)P.xd_lat + (size_t)mr[q] * DM) + lane + 64 * j); } }
    if (P.xn) {
        float ss[2];
#pragma unroll
        for (int q = 0; q < 2; ++q) { ss[q] = 0.f;
#pragma unroll
            for (int j = 0; j < 4; ++j) ss[q] += (v[q][j].x * v[q][j].x + v[q][j].y * v[q][j].y) + (v[q][j].z * v[q][j].z + v[q][j].w * v[q][j].w); }
#pragma unroll
        for (int o = 1; o < 64; o <<= 1) { ss[0] += __shfl_xor(ss[0], o); ss[1] += __shfl_xor(ss[1], o); }
#pragma unroll
        for (int q = 0; q < 2; ++q) { const float rstd = rsqrtf(ss[q] * (1.f / DM) + EPS); const int mrow = mr[q] >> 11; v2u* xo = (v2u*)(P.xn + (size_t)mr[q] * DM);
#pragma unroll
            for (int j = 0; j < 4; ++j) { const f32x4 n4 = ((const f32x4*)P.ngx)[lane + 64 * j]; const f32x4 sc = ((const f32x4*)(P.scale + (size_t)mrow * 6144))[lane + 64 * j];
                const f32x4 sh = ((const f32x4*)(P.shift + (size_t)mrow * 6144))[lane + 64 * j];
                const f32x4 y = ((v[q][j] * rstd) * n4) * (sc + 1.f) + sh; v2u w; w.x = pk2(y.x, y.y); w.y = pk2(y.z, y.w); xo[lane + 64 * j] = w; } }
    }
}
template <int XS, int XD>
__device__ __forceinline__ void row_raw_compute1(const RowPass& P, const RowRaw<XS>& R, const int q, int m, int lane) {
    f32x4 v[4];
#pragma unroll
    for (int j = 0; j < 4; ++j) { if constexpr (XS == 1) v[j] = bf4(R.x[q][j]); else v[j] = R.x[q][j]; }
    const int mrow = m >> 11;
    if (P.o) {
        f32x4 ov[4]; float ss = 0.f;
#pragma unroll
        for (int j = 0; j < 4; ++j) { ov[j] = bf4(R.o[q][j]); ss += (ov[j].x * ov[j].x + ov[j].y * ov[j].y) + (ov[j].z * ov[j].z + ov[j].w * ov[j].w); }
#pragma unroll
        for (int o = 1; o < 64; o <<= 1) ss += __shfl_xor(ss, o);
        const float rstd = rsqrtf(ss * (1.f / DM) + EPS);
#pragma unroll
        for (int j = 0; j < 4; ++j) { const f32x4 g4 = ((const f32x4*)(P.gate + (size_t)mrow * 6144))[lane + 64 * j]; const f32x4 n4 = ((const f32x4*)P.ngo)[lane + 64 * j];
            v[j] = v[j] + g4 * ((ov[j] * rstd) * n4); }
    }
    if (P.xd_lat) {
#pragma unroll
        for (int j = 0; j < 4; ++j) {
            if constexpr (XD == 1) { v2u w; w.x = pk2(v[j].x, v[j].y); w.y = pk2(v[j].z, v[j].w); __builtin_nontemporal_store(w, (v2u*)((bf16*)P.xd_lat + (size_t)m * DM) + lane + 64 * j); }
            else __builtin_nontemporal_store(v[j], (f32x4*)((float*)P.xd_lat + (size_t)m * DM) + lane + 64 * j); } }
    if (P.xn) {
        float ss = 0.f;
#pragma unroll
        for (int j = 0; j < 4; ++j) ss += (v[j].x * v[j].x + v[j].y * v[j].y) + (v[j].z * v[j].z + v[j].w * v[j].w);
#pragma unroll
        for (int o = 1; o < 64; o <<= 1) ss += __shfl_xor(ss, o);
        const float rstd = rsqrtf(ss * (1.f / DM) + EPS); v2u* xo = (v2u*)(P.xn + (size_t)m * DM);
#pragma unroll
        for (int j = 0; j < 4; ++j) { const f32x4 n4 = ((const f32x4*)P.ngx)[lane + 64 * j]; const f32x4 sc = ((const f32x4*)(P.scale + (size_t)mrow * 6144))[lane + 64 * j];
            const f32x4 sh = ((const f32x4*)(P.shift + (size_t)mrow * 6144))[lane + 64 * j];
            const f32x4 y = ((v[j] * rstd) * n4) * (sc + 1.f) + sh; v2u w; w.x = pk2(y.x, y.y); w.y = pk2(y.z, y.w); xo[lane + 64 * j] = w; }
    }
}
struct RowRange { int m0, stride, mlend, mc0, mcend; };
template <int XS, int XD, bool QUAD = (XS == 1), int NSLAB = 8>
__device__ __forceinline__ void row_pass(Frame& F, const RowPass& P, const RowRange R) {
    const int NGW = R.stride, lane = F.lane;
    const int Ml = R.mlend;
    int m = R.m0;
    if constexpr (QUAD) {
        if (m + 3 * NGW < Ml) {
            RowRaw<XS> c0, c1; row_raw_load<XS>(P, c0, m, m + NGW, lane); row_raw_load<XS>(P, c1, m + 2 * NGW, m + 3 * NGW, lane);
            for (;;) {
                const int mn = m + 4 * NGW; const bool more = mn + 3 * NGW < Ml;
                RowRaw<XS> n0, n1;
                if (more) { row_raw_load<XS>(P, n0, mn, mn + NGW, lane); row_raw_load<XS>(P, n1, mn + 2 * NGW, mn + 3 * NGW, lane); }
                row_raw_compute1<XS, XD>(P, c0, 0, m, lane); row_raw_compute1<XS, XD>(P, c0, 1, m + NGW, lane);
                row_raw_compute1<XS, XD>(P, c1, 0, m + 2 * NGW, lane); row_raw_compute1<XS, XD>(P, c1, 1, m + 3 * NGW, lane);
                m = mn;
                if (!more) break;
                c0 = n0; c1 = n1;
            }
        }
    }
    if (m + NGW < Ml) {
        RowRaw<XS> cur; row_raw_load<XS>(P, cur, m, m + NGW, lane);
        for (;;) {
            const int mn = m + 2 * NGW; const bool more = mn + NGW < Ml;
            RowRaw<XS> nxt;
            if (more) row_raw_load<XS>(P, nxt, mn, mn + NGW, lane);
            row_raw_compute<XS, XD>(P, cur, m, m + NGW, lane);
            m = mn;
            if (!more) break;
            cur = nxt;
        }
    }
    for (; m < Ml; m += NGW) { const int mr[1] = {m}; row_pass_rows<1, XS, XD, NSLAB>(P, mr, lane); }
    for (int mc = R.mc0; mc < R.mcend; mc += NGW) { const int mr[1] = {mc}; row_pass_rows<1, XS, XD, NSLAB>(P, mr, lane); }
}

constexpr int ROPE_LDS_OFF = 131072;
__device__ __forceinline__ void fill_rope_table(Frame& F) {
    LAS float* tab = (LAS float*)(F.lds + ROPE_LDS_OFF);
    for (int i = F.tid; i < 1024; i += NWAVES * 64) { const int pos = i >> 4, j = i & 15; const float rev = (float)pos * exp2f(-(float)j * 0.83048202372184058696f) * 0.15915494309189533577f; const float fr = rev - floorf(rev);
        tab[2 * i] = __builtin_amdgcn_cosf(fr); tab[2 * i + 1] = __builtin_amdgcn_sinf(fr); }
    __syncthreads();
}
struct EpiProj {
    static constexpr bool PERM = true, AFTER_DRAIN = false;
    bf16* O; const float* qn; const float* kn; const LAS float* rope;
    __device__ __forceinline__ void operator()(const pg8::f32x4 (&acc)[2][2][4][2], const pg8::Unit& u, int wr, int wc, int fr, int fq) const {
        const int row0 = u.pm * 256 + wr * 64 + fr;
        if (u.pn >= 4) {
#pragma unroll
            for (int ai = 0; ai < 2; ++ai)
#pragma unroll
                for (int m = 0; m < 4; ++m) { bf16* rowp = O + (size_t)(row0 + ai * 128 + m * 16) * NPROJ;
#pragma unroll
                    for (int bj = 0; bj < 2; ++bj) { const int pos = u.pn * 256 + bj * 128 + wc * 32 + 8 * fq; const int col = pos < 1152 ? pos - 512 : pos;
                        const pg8::f32x4 v0 = acc[ai][bj][m][0], v1 = acc[ai][bj][m][1];
                        v4u w; w.x = pk2(v0[0], v0[1]); w.y = pk2(v0[2], v0[3]); w.z = pk2(v1[0], v1[1]); w.w = pk2(v1[2], v1[3]);
                        st16_wt(rowp + col, w); } }
            return;
        }
        const int pn = u.pn; const bool att = pn < 2, iskatt = (pn == 1) && (wc >= 2), lat = u.pm < MLAT / 256;
        const int hb = pn == 0 ? wc * 64 : pn == 1 ? (wc < 2 ? (4 + wc) * 64 : C_KA + (wc - 2) * 64) : pn == 2 ? C_QR + wc * 64 : C_KR + wc * 64;
        const float scl = att ? (iskatt ? 1.f : QSCALE) : (pn == 3 ? 0.125f : 1.f);
        float gn[2][8];
        { const float* gp = iskatt ? kn : qn;
#pragma unroll
          for (int bj = 0; bj < 2; ++bj) { const f32x4 a = *(const f32x4*)(gp + 32 * bj + 8 * fq), b = *(const f32x4*)(gp + 32 * bj + 8 * fq + 4);
              gn[bj][0] = a.x; gn[bj][1] = a.y; gn[bj][2] = a.z; gn[bj][3] = a.w; gn[bj][4] = b.x; gn[bj][5] = b.y; gn[bj][6] = b.z; gn[bj][7] = b.w; } }
        const bool up = (fq >> 1) & 1; const int jb = 8 * (fq & 1);
#pragma unroll
        for (int ai = 0; ai < 2; ++ai)
#pragma unroll
            for (int m = 0; m < 4; ++m) {
                const int r = row0 + ai * 128 + m * 16; float x[2][8];
#pragma unroll
                for (int bj = 0; bj < 2; ++bj)
#pragma unroll
                    for (int e = 0; e < 8; ++e) x[bj][e] = acc[ai][bj][m][e >> 2][e & 3];
                if (att) { float ss = 0.f;
#pragma unroll
                    for (int bj = 0; bj < 2; ++bj)
#pragma unroll
                        for (int e = 0; e < 8; ++e) ss += x[bj][e] * x[bj][e];
                    ss += __shfl_xor(ss, 16); ss += __shfl_xor(ss, 32);
                    const float rstd = rsqrtf(ss * (1.f / 64.f) + EPS);
#pragma unroll
                    for (int bj = 0; bj < 2; ++bj)
#pragma unroll
                        for (int e = 0; e < 8; ++e) x[bj][e] = (x[bj][e] * rstd) * gn[bj][e]; }
                if (lat) { const int t = r & (SEQ - 1);
#pragma unroll
                    for (int bj = 0; bj < 2; ++bj) { const int pos = bj ? (t & 63) : (t >> 6); const LAS f32x4* tp = (const LAS f32x4*)(rope + (pos * 16 + jb) * 2);
                        const f32x4 t0 = tp[0], t1 = tp[1], t2 = tp[2], t3 = tp[3];
                        const float cs[8] = {t0.x, t0.z, t1.x, t1.z, t2.x, t2.z, t3.x, t3.z}, sn[8] = {t0.y, t0.w, t1.y, t1.w, t2.y, t2.w, t3.y, t3.w};
#pragma unroll
                        for (int e = 0; e < 8; ++e) { const float pr = __shfl_xor(x[bj][e], 32); x[bj][e] = up ? (x[bj][e] * cs[e] + pr * sn[e]) : (x[bj][e] * cs[e] - pr * sn[e]); } } }
                bf16* rowp = O + (size_t)r * NPROJ + hb + 8 * fq;
#pragma unroll
                for (int bj = 0; bj < 2; ++bj) { v4u w; w.x = pk2(x[bj][0] * scl, x[bj][1] * scl); w.y = pk2(x[bj][2] * scl, x[bj][3] * scl); w.z = pk2(x[bj][4] * scl, x[bj][5] * scl); w.w = pk2(x[bj][6] * scl, x[bj][7] * scl);
                    st16_wt(rowp + 32 * bj, w); }
            }
    }
};
__device__ __forceinline__ void prep_rows(const Args& A, unsigned char* ws, int layer, int rowbase, int nrows, int rowbase2, int nrows2, int gt, int NGT) {
    bf16* PROJ = (bf16*)(ws + WS_BIG); bf16* XBC2 = (bf16*)(ws + WS_XBC2); float* DTLA = (float*)(ws + WS_DTLA);
    {
        const float* cw = A.in[14] + (size_t)layer * 5 * XBW; const float* cb = A.in[15] + (size_t)layer * XBW;
        constexpr int NCH = XBW / 8; const int NIT = ((nrows + nrows2) / 16) * NCH;
        for (int it = gt; it < NIT; it += NGT) {
            const int run = it / NCH, ch = it % NCH, c0 = ch * 8, row0 = run < nrows / 16 ? rowbase + run * 16 : rowbase2 + (run - nrows / 16) * 16;
            const int sbeg = row0 < MLAT ? (row0 & ~(SEQ - 1)) : MLAT + ((row0 - MLAT) & ~(LCTX - 1));
            const int send = sbeg + (row0 < MLAT ? SEQ : LCTX);
            float w[5][8], bias[8];
#pragma unroll
            for (int t = 0; t < 5; ++t) { const f32x4 a = *(const f32x4*)(cw + t * XBW + c0), b = *(const f32x4*)(cw + t * XBW + c0 + 4);
                w[t][0] = a.x; w[t][1] = a.y; w[t][2] = a.z; w[t][3] = a.w; w[t][4] = b.x; w[t][5] = b.y; w[t][6] = b.z; w[t][7] = b.w; }
            { const f32x4 a = *(const f32x4*)(cb + c0), b = *(const f32x4*)(cb + c0 + 4); bias[0] = a.x; bias[1] = a.y; bias[2] = a.z; bias[3] = a.w; bias[4] = b.x; bias[5] = b.y; bias[6] = b.z; bias[7] = b.w; }
            v4u rows[20];
#pragma unroll
            for (int t = 0; t < 20; ++t) { const int r = row0 - 2 + t; const bool in = (r >= sbeg && r < send); const int rc = in ? r : row0; const unsigned mk = in ? 0xffffffffu : 0u;
                v4u v = __builtin_nontemporal_load((const v4u*)(PROJ + (size_t)rc * NPROJ + C_XBC + c0)); v.x &= mk; v.y &= mk; v.z &= mk; v.w &= mk; rows[t] = v; }
#pragma unroll
            for (int rr = 0; rr < 16; ++rr) {
                float acc[8];
#pragma unroll
                for (int e = 0; e < 8; ++e) acc[e] = bias[e];
#pragma unroll
                for (int t = 0; t < 5; ++t) {
#pragma unroll
                    for (int e2 = 0; e2 < 4; ++e2) { const unsigned u = rows[rr + t][e2]; acc[2 * e2] += w[t][2 * e2] * bflo(u); acc[2 * e2 + 1] += w[t][2 * e2 + 1] * bfhi(u); } }
                v4u o;
#pragma unroll
                for (int e2 = 0; e2 < 4; ++e2) o[e2] = pk2(acc[2 * e2] * __builtin_amdgcn_rcpf(1.f + __expf(-acc[2 * e2])), acc[2 * e2 + 1] * __builtin_amdgcn_rcpf(1.f + __expf(-acc[2 * e2 + 1])));
                st16_wt(XBC2 + (size_t)(row0 + rr) * XBW + c0, o);
            }
        }
    }
    {
        const float* dtb = A.in[16] + layer * 12; const float* alog = A.in[17] + layer * 12;
        for (int it = gt; it < (nrows + nrows2) * 3; it += NGT) {
            const int rq = it / 3, q = it % 3, row = rq < nrows ? rowbase + rq : rowbase2 + (rq - nrows);
            const v2u raw = __builtin_nontemporal_load((const v2u*)(PROJ + (size_t)row * NPROJ + C_DT + 4 * q));
            const f32x4 bq = *(const f32x4*)(dtb + 4 * q), aq = *(const f32x4*)(alog + 4 * q);
            const float xr[4] = {bflo(raw.x), bfhi(raw.x), bflo(raw.y), bfhi(raw.y)}; f32x4 dt4, la4;
#pragma unroll
            for (int e = 0; e < 4; ++e) { const float xv = xr[e] + bq[e]; const float dt = xv > 20.f ? xv : log1pf(expf(xv)); dt4[e] = dt; la4[e] = -dt * expf(aq[e]); }
            st16_wt(DTLA + (size_t)row * 24 + 4 * q, __builtin_bit_cast(v4u, dt4)); st16_wt(DTLA + (size_t)row * 24 + 12 + 4 * q, __builtin_bit_cast(v4u, la4));
        }
    }
}
constexpr int AT_KSTR = 144, AT_VSTR = 192, AT_TK = 128, AT_KBYTES = AT_TK * AT_KSTR, AT_VBYTES = AT_TK * AT_VSTR;
constexpr float AT_THR = 6.0f;
__device__ __forceinline__ void attn_unit(LAS unsigned char* lds, const bf16* PROJ, bf16* MIXA, const float* qn, const float* kn, int b, int hq, int qrow0, int kt0, int nkt, int tid, int lane, int wave) {
    const int g = hq / 3, r32 = lane & 31, hi = lane >> 5;
    const GAS bf16* PROJg = (const GAS bf16*)PROJ; GAS bf16* MIXAg = (GAS bf16*)MIXA;
    LAS unsigned char* QP = lds + 2 * AT_KBYTES + 2 * AT_VBYTES + wave * 4096 + lane * 16;
    bf16x8 qf_in[4];
    { const GAS bf16* qp = PROJg + (size_t)(qrow0 + wave * 32 + r32) * NPROJ + C_QA + hq * 64 + hi * 8;
#pragma unroll
      for (int d0 = 0; d0 < 4; ++d0) qf_in[d0] = *(const GAS bf16x8*)(qp + d0 * 16); }
    const int lkey = tid >> 3, lch = tid & 7;
    const GAS bf16* kcol = PROJg + C_KA + g * 64 + lch * 8; const GAS bf16* vcol = PROJg + C_VA + g * 64 + lch * 8;
    LAS unsigned char* KB = lds; LAS unsigned char* VB = lds + 2 * AT_KBYTES;
    const int kwoff = lkey * AT_KSTR + lch * 16, vwoff = lkey * AT_VSTR + lch * 16;
    const int kroff = r32 * AT_KSTR + hi * 16;
    const int vroff = (4 * hi + ((lane & 15) >> 2)) * AT_VSTR + (((lane >> 4) & 1) * 16 + (lane & 3) * 4) * 2;
    float m = 0.f, lsum = 0.f; f32x16 o0, o1, negm, zero16;
#pragma unroll
    for (int r = 0; r < 16; ++r) { o0[r] = 0.f; o1[r] = 0.f; negm[r] = 0.f; zero16[r] = 0.f; }
    v4u kreg[2], vreg[2];
#define AT_LOAD(kt) do { _Pragma("unroll") for (int h2 = 0; h2 < 2; ++h2) { const int kk = (kt) * AT_TK + h2 * 64 + lkey; \
        const size_t row = kk < SEQ ? (size_t)b * SEQ + kk : (size_t)MLAT + b * LCTX + (kk - SEQ); kreg[h2] = *(const GAS v4u*)(kcol + row * NPROJ); vreg[h2] = *(const GAS v4u*)(vcol + row * NPROJ); } } while (0)
#define AT_STORE(buf) do { _Pragma("unroll") for (int h2 = 0; h2 < 2; ++h2) { *(LAS v4u*)(KB + (buf) * AT_KBYTES + h2 * 64 * AT_KSTR + kwoff) = kreg[h2]; \
        *(LAS v4u*)(VB + (buf) * AT_VBYTES + h2 * 64 * AT_VSTR + vwoff) = vreg[h2]; } } while (0)
#define AT_QK(P0, P1, Kc, DYN) do { { const bf16x8 a0 = *(const LAS bf16x8*)(Kc), a1 = *(const LAS bf16x8*)((Kc) + 32 * AT_KSTR), q = (DYN) ? *(const LAS bf16x8*)(QP) : qf_in[0]; \
            P0 = MFMA32(a0, q, (DYN) ? negm : zero16); P1 = MFMA32(a1, q, (DYN) ? negm : zero16); } \
        _Pragma("unroll") for (int d0 = 1; d0 < 4; ++d0) { const bf16x8 a0 = *(const LAS bf16x8*)((Kc) + d0 * 32), a1 = *(const LAS bf16x8*)((Kc) + 32 * AT_KSTR + d0 * 32), q = (DYN) ? *(const LAS bf16x8*)(QP + d0 * 1024) : qf_in[d0]; \
            P0 = MFMA32(a0, q, P0); P1 = MFMA32(a1, q, P1); } } while (0)
#define AT_STEP(C0, C1, N0, N1, Kn, Vc, HASN, DYN) do { if (DYN) { \
        float mxa = max3f(C0[0], C0[1], C1[0]), mxb = max3f(C0[2], C0[3], C1[1]); mxa = max3f(mxa, C1[2], C1[3]); \
        _Pragma("unroll") for (int r = 4; r < 16; r += 4) { mxa = max3f(mxa, C0[r], C0[r + 1]); mxb = max3f(mxb, C0[r + 2], C0[r + 3]); mxa = max3f(mxa, C1[r], C1[r + 1]); mxb = max3f(mxb, C1[r + 2], C1[r + 3]); } \
        float mx = max3f(mxa, mxb, mxb); mx = max3f(mx, __shfl_xor(mx, 32), mx); \
        if (first || __any(mx > AT_THR)) { const float dl = first ? mx : fmaxf(mx, 0.f); m += dl; const float alpha = __builtin_amdgcn_exp2f(-dl); \
            _Pragma("unroll") for (int r = 0; r < 16; ++r) { C0[r] -= dl; C1[r] -= dl; o0[r] *= alpha; o1[r] *= alpha; negm[r] = -m; } \
            lsum *= alpha; first = false; } } \
        if (HASN) AT_QK(N0, N1, Kn, DYN); \
        float rs = 0.f; \
        _Pragma("unroll") for (int r = 0; r < 16; ++r) { C0[r] = __builtin_amdgcn_exp2f(C0[r]); C1[r] = __builtin_amdgcn_exp2f(C1[r]); rs += C0[r] + C1[r]; } \
        lsum += rs; \
        bf16x8 pf[4]; \
        _Pragma("unroll") for (int s = 0; s < 4; ++s) { v4u w; \
            _Pragma("unroll") for (int e = 0; e < 4; ++e) { const int r = 8 * (s & 1) + 2 * e; w[e] = (s < 2) ? pk2(C0[r], C0[r + 1]) : pk2(C1[r], C1[r + 1]); } \
            pf[s] = __builtin_bit_cast(bf16x8, w); } \
        _Pragma("unroll") for (int s = 0; s < 4; ++s) { \
            const s16x4 a_lo = tr16((Vc) + (16 * s) * AT_VSTR), a_hi = tr16((Vc) + (16 * s + 8) * AT_VSTR); \
            const s16x4 b_lo = tr16((Vc) + (16 * s) * AT_VSTR + 64), b_hi = tr16((Vc) + (16 * s + 8) * AT_VSTR + 64); \
            o0 = MFMA32(CAT8(a_lo, a_hi), pf[s], o0); o1 = MFMA32(CAT8(b_lo, b_hi), pf[s], o1); } } while (0)
#define AT_FENCE __builtin_amdgcn_sched_barrier(0)
#define AT_E(C, r) do { C[r] = __builtin_amdgcn_exp2f(C[r]); C[(r) + 1] = __builtin_amdgcn_exp2f(C[(r) + 1]); } while (0)
#define AT_A(C, r, W) do { rs += C[r]; rs2 += C[(r) + 1]; W = pk2(C[r], C[(r) + 1]); } while (0)
#define AT_VRD(V, s) do { V[0] = tr16((Vc_) + (16 * (s)) * AT_VSTR); V[1] = tr16((Vc_) + (16 * (s) + 8) * AT_VSTR); V[2] = tr16((Vc_) + (16 * (s)) * AT_VSTR + 64); V[3] = tr16((Vc_) + (16 * (s) + 8) * AT_VSTR + 64); } while (0)
#define AT_STEP_S(C0, C1, N0, N1, Kn, Vc, HASN) do { \
        const LAS unsigned char* Vc_ = (Vc); bf16x8 ka[4], kb[4]; s16x4 va[4], vb[4]; v4u w0, w1, w2, w3; float rs = 0.f, rs2 = 0.f; \
        if (HASN) { _Pragma("unroll") for (int d0 = 0; d0 < 4; ++d0) { ka[d0] = *(const LAS bf16x8*)((Kn) + d0 * 32); kb[d0] = *(const LAS bf16x8*)((Kn) + 32 * AT_KSTR + d0 * 32); } } \
        AT_FENCE; AT_E(C0, 0); \
        AT_FENCE; AT_VRD(va, 0); AT_E(C0, 2); AT_A(C0, 0, w0[0]); \
        AT_FENCE; if (HASN) N0 = MFMA32(ka[0], qf_in[0], zero16); AT_E(C0, 4); AT_A(C0, 2, w0[1]); \
        AT_FENCE; if (HASN) N1 = MFMA32(kb[0], qf_in[0], zero16); AT_E(C0, 6); AT_A(C0, 4, w0[2]); \
        AT_FENCE; if (HASN) N0 = MFMA32(ka[1], qf_in[1], N0); AT_E(C0, 8); AT_A(C0, 6, w0[3]); \
        AT_FENCE; if (HASN) N1 = MFMA32(kb[1], qf_in[1], N1); AT_VRD(vb, 1); AT_E(C0, 10); AT_A(C0, 8, w1[0]); \
        AT_FENCE; o0 = MFMA32(CAT8(va[0], va[1]), __builtin_bit_cast(bf16x8, w0), o0); AT_E(C0, 12); AT_A(C0, 10, w1[1]); \
        AT_FENCE; o1 = MFMA32(CAT8(va[2], va[3]), __builtin_bit_cast(bf16x8, w0), o1); AT_E(C0, 14); AT_A(C0, 12, w1[2]); \
        AT_FENCE; if (HASN) N0 = MFMA32(ka[2], qf_in[2], N0); AT_E(C1, 0); AT_A(C0, 14, w1[3]); \
        AT_FENCE; if (HASN) N1 = MFMA32(kb[2], qf_in[2], N1); AT_VRD(va, 2); AT_E(C1, 2); AT_A(C1, 0, w2[0]); \
        AT_FENCE; o0 = MFMA32(CAT8(vb[0], vb[1]), __builtin_bit_cast(bf16x8, w1), o0); AT_E(C1, 4); AT_A(C1, 2, w2[1]); \
        AT_FENCE; o1 = MFMA32(CAT8(vb[2], vb[3]), __builtin_bit_cast(bf16x8, w1), o1); AT_E(C1, 6); AT_A(C1, 4, w2[2]); \
        AT_FENCE; if (HASN) N0 = MFMA32(ka[3], qf_in[3], N0); AT_E(C1, 8); AT_A(C1, 6, w2[3]); \
        AT_FENCE; if (HASN) N1 = MFMA32(kb[3], qf_in[3], N1); AT_VRD(vb, 3); AT_E(C1, 10); AT_A(C1, 8, w3[0]); \
        AT_FENCE; o0 = MFMA32(CAT8(va[0], va[1]), __builtin_bit_cast(bf16x8, w2), o0); AT_E(C1, 12); AT_A(C1, 10, w3[1]); \
        AT_FENCE; o1 = MFMA32(CAT8(va[2], va[3]), __builtin_bit_cast(bf16x8, w2), o1); AT_E(C1, 14); AT_A(C1, 12, w3[2]); \
        AT_FENCE; AT_A(C1, 14, w3[3]); o0 = MFMA32(CAT8(vb[0], vb[1]), __builtin_bit_cast(bf16x8, w3), o0); o1 = MFMA32(CAT8(vb[2], vb[3]), __builtin_bit_cast(bf16x8, w3), o1); lsum += rs + rs2; \
        AT_FENCE; } while (0)
    AT_LOAD(kt0);
    __syncthreads();
#pragma unroll
    for (int d0 = 0; d0 < 4; ++d0) *(LAS bf16x8*)(QP + d0 * 1024) = qf_in[d0];
    AT_STORE(0);
    if (nkt > 1) AT_LOAD(kt0 + 1);
    __syncthreads();
    bool first = true;
    f32x16 pA0, pA1, pB0, pB1;
    float Mb;
    { float gq = fabsf(((const GAS float*)qn)[lane]), gk = fabsf(((const GAS float*)kn)[lane]);
#pragma unroll
      for (int o = 1; o < 64; o <<= 1) { gq = fmaxf(gq, __shfl_xor(gq, o)); gk = fmaxf(gk, __shfl_xor(gk, o)); }
      Mb = 8.25f * LOG2E * gq * gk; }
#define AT_LOOP(DYN) do { \
    AT_QK(pA0, pA1, KB + kroff, DYN); \
    for (int t = 0; t < nkt; ++t) { \
        const int cur = t & 1; \
        if (t + 1 < nkt) AT_STORE(cur ^ 1); \
        if (t + 2 < nkt) AT_LOAD(kt0 + t + 2); \
        const LAS unsigned char* Kc = KB + cur * AT_KBYTES + kroff; const LAS unsigned char* Vc = VB + cur * AT_VBYTES + vroff; \
        AT_STEP(pA0, pA1, pB0, pB1, Kc + 64 * AT_KSTR, Vc, true, DYN); \
        __syncthreads(); \
        const LAS unsigned char* Kn = KB + (cur ^ 1) * AT_KBYTES + kroff; \
        AT_STEP(pB0, pB1, pA0, pA1, Kn, Vc + 64 * AT_VSTR, (t + 1 < nkt), DYN); \
        __syncthreads(); \
    } } while (0)
#define AT_LOOP_S() do { \
    AT_QK(pA0, pA1, KB + kroff, 0); \
    for (int t = 0; t < nkt; ++t) { \
        const int cur = t & 1; \
        if (t + 1 < nkt) AT_STORE(cur ^ 1); \
        if (t + 2 < nkt) AT_LOAD(kt0 + t + 2); \
        const LAS unsigned char* Kc = KB + cur * AT_KBYTES + kroff; const LAS unsigned char* Vc = VB + cur * AT_VBYTES + vroff; \
        AT_STEP_S(pA0, pA1, pB0, pB1, Kc + 64 * AT_KSTR, Vc, true); \
        __syncthreads(); \
        const LAS unsigned char* Kn = KB + (cur ^ 1) * AT_KBYTES + kroff; \
        AT_STEP_S(pB0, pB1, pA0, pA1, Kn, Vc + 64 * AT_VSTR, (t + 1 < nkt)); \
        __syncthreads(); \
    } } while (0)
    if (Mb < 60.f) AT_LOOP_S();
    else AT_LOOP(1);
#undef AT_LOOP
#undef AT_LOOP_S
#undef AT_STEP_S
#undef AT_E
#undef AT_A
#undef AT_VRD
#undef AT_FENCE
#undef AT_QK
#undef AT_STEP
#undef AT_LOAD
#undef AT_STORE
    lsum += __shfl_xor(lsum, 32);
    const float inv = 1.f / lsum;
    GAS bf16* op = MIXAg + (size_t)(qrow0 + wave * 32 + r32) * DM + hq * 64 + 8 * hi;
#pragma unroll
    for (int p = 0; p < 2; ++p) {
#pragma unroll
        for (int h2 = 0; h2 < 2; ++h2) {
            const int ga = 8 * p, gb = 8 * p + 4;
            unsigned ax, ay, bx, by;
            if (h2 == 0) { ax = pk2(o0[ga] * inv, o0[ga + 1] * inv); ay = pk2(o0[ga + 2] * inv, o0[ga + 3] * inv); bx = pk2(o0[gb] * inv, o0[gb + 1] * inv); by = pk2(o0[gb + 2] * inv, o0[gb + 3] * inv); }
            else         { ax = pk2(o1[ga] * inv, o1[ga + 1] * inv); ay = pk2(o1[ga + 2] * inv, o1[ga + 3] * inv); bx = pk2(o1[gb] * inv, o1[gb + 1] * inv); by = pk2(o1[gb + 2] * inv, o1[gb + 3] * inv); }
            const auto r0 = __builtin_amdgcn_permlane32_swap(ax, bx, false, false); const auto r1 = __builtin_amdgcn_permlane32_swap(ay, by, false, false);
            v4u w; w.x = r0[0]; w.y = r1[0]; w.z = r0[1]; w.w = r1[1];
            st16_wt((const void*)(op + 32 * h2 + 16 * p), w);
        }
    }
}
template <int N>
__device__ __forceinline__ void rec_unit(LAS unsigned char* lds, int tid, int lane, int wave,
                                         const bf16* Qg, const bf16* Kg, const bf16* Vg, int pitch,
                                         const float* dtla, int dt_off, int la_off, float la_const,
                                         bf16* Yg, int ypitch, int b, bool rev, bool ctx_out) {
    constexpr int QSTR = N * 2 + 16, VSTR = 144;
    constexpr int KB_ = 128 * QSTR, VB_ = 128 * VSTR, SB_ = 64 * QSTR, FB_ = 2560;
    constexpr int OFF_K = 0, OFF_V = 2 * KB_, OFF_S = OFF_V + 2 * VB_, OFF_F = OFF_S + 2 * SB_;
    static_assert(OFF_F + 2 * FB_ <= LDSCTL_OFF, "rec_unit LDS map");
    constexpr int NT = N / 16, KS = N / 32, TPW = NT / 2, CPR = N / 8, NLD = CPR / 4;
    const int c = lane & 15, quad = lane >> 4, q4 = c >> 2, p4 = c & 3;
    const GAS bf16* Qgg = (const GAS bf16*)Qg; const GAS bf16* Kgg = (const GAS bf16*)Kg; const GAS bf16* Vgg = (const GAS bf16*)Vg; const GAS float* dtg = (const GAS float*)dtla; GAS bf16* Ygg = (GAS bf16*)Yg;
    const int own_nt = wave % NT, own_pt0 = (wave / NT) * TPW;
    const int itile = wave < 4 ? wave : 11 - wave;
    const int icol = 16 * itile + c;
    f32x4 sacc[TPW];
#pragma unroll
    for (int i = 0; i < TPW; ++i) sacc[i] = (f32x4){0.f, 0.f, 0.f, 0.f};
    v4u rk[NLD], rv[2]; bf16x8 qn[KS]; float la0 = la_const, la1 = la_const, s0 = 1.f, s1 = 1.f;
#define RC_GEOM(ci_) const bool isctx_ = (ci_) < 2; const int cc_ = isctx_ ? (ci_) : (ci_) - 2; const int sbase_ = isctx_ ? MLAT + b * LCTX : b * SEQ, slen_ = isctx_ ? LCTX : SEQ; \
        const int pos0_ = rev ? (slen_ - 1 - cc_ * 128) : cc_ * 128, pstep_ = rev ? -1 : 1;
#define RC_LOAD(ci_) do { RC_GEOM(ci_) \
        _Pragma("unroll") for (int k = 0; k < NLD; ++k) { const int idx = tid + k * 512, ip = idx / CPR, ch = idx % CPR; const size_t row = (size_t)(sbase_ + pos0_ + pstep_ * ip); \
            rk[k] = *(const GAS v4u*)(Kgg + row * pitch + ch * 8); } \
        _Pragma("unroll") for (int k = 0; k < 2; ++k) { const int idx = tid + k * 512, ip = idx >> 3, ch = idx & 7; const size_t row = (size_t)(sbase_ + pos0_ + pstep_ * ip); \
            rv[k] = *(const GAS v4u*)(Vgg + row * pitch + ch * 8); } \
        { const GAS bf16* qp = Qgg + (size_t)(sbase_ + pos0_ + pstep_ * icol) * pitch + quad * 8; \
          _Pragma("unroll") for (int ks = 0; ks < KS; ++ks) qn[ks] = *(const GAS bf16x8*)(qp + ks * 32); } \
        if (wave == 0 && dtla) { const size_t r0 = (size_t)(sbase_ + pos0_ + pstep_ * (2 * lane)), r1 = (size_t)(sbase_ + pos0_ + pstep_ * (2 * lane + 1)); \
            la0 = dtg[r0 * 24 + la_off]; la1 = dtg[r1 * 24 + la_off]; s0 = dtg[r0 * 24 + dt_off]; s1 = dtg[r1 * 24 + dt_off]; } } while (0)
#define RC_STORE(bf_) do { \
        _Pragma("unroll") for (int k = 0; k < NLD; ++k) { const int idx = tid + k * 512, ip = idx / CPR, ch = idx % CPR; *(LAS v4u*)(lds + OFF_K + (bf_) * KB_ + ip * QSTR + ch * 16) = rk[k]; } \
        _Pragma("unroll") for (int k = 0; k < 2; ++k) { const int idx = tid + k * 512, ip = idx >> 3, ch = idx & 7; *(LAS v4u*)(lds + OFF_V + (bf_) * VB_ + ip * VSTR + ch * 16) = rv[k]; } } while (0)
#define RC_CUM(bf_) do { if (wave == 0) { LAS float* CUMw = (LAS float*)(lds + OFF_F + (bf_) * FB_); \
            const float pair = la0 + la1; float v = pair; \
            _Pragma("unroll") for (int o = 1; o < 64; o <<= 1) { const float t = __shfl_up(v, o); if (lane >= o) v += t; } \
            const float c1 = v, c0 = (v - pair) + la0, last = __shfl(v, 63); \
            CUMw[2 * lane] = c0 * LOG2E; CUMw[2 * lane + 1] = c1 * LOG2E; \
            CUMw[128 + 2 * lane] = __expf(c0); CUMw[128 + 2 * lane + 1] = __expf(c1); \
            CUMw[256 + 2 * lane] = s0 * __expf(last - c0); CUMw[256 + 2 * lane + 1] = s1 * __expf(last - c1); \
            CUMw[384 + 2 * lane] = s0; CUMw[384 + 2 * lane + 1] = s1; \
            if (lane == 0) CUMw[512] = __expf(last); } } while (0)
    RC_LOAD(0);
    __syncthreads();
    for (int i = tid; i < SB_ / 4; i += NWAVES * 64) ((LAS unsigned*)(lds + OFF_S))[i] = 0u;
    RC_STORE(0); RC_CUM(0);
    bf16x8 qf[KS];
#pragma unroll
    for (int ks = 0; ks < KS; ++ks) qf[ks] = qn[ks];
    RC_LOAD(1);
    __syncthreads();
    for (int ci = 0; ci < 18; ++ci) {
        RC_GEOM(ci)
        const int cur = ci & 1;
        const LAS unsigned char* Kc = lds + OFF_K + cur * KB_; const LAS unsigned char* Vc = lds + OFF_V + cur * VB_; const LAS unsigned char* Sc = lds + OFF_S + cur * SB_;
        const LAS float* CUM = (const LAS float*)(lds + OFF_F + cur * FB_); const LAS float* ECUM = CUM + 128; const LAS float* WJ = CUM + 256; const LAS float* SJ = CUM + 384;
        const float cum_i = CUM[icol], ecum_i = ECUM[icol];
        const bool want_y = !isctx_ || ctx_out;
        if (want_y) {
            f32x4 ya[4];
            {   bf16x8 sf[4][KS];
#pragma unroll
                for (int pt = 0; pt < 4; ++pt)
#pragma unroll
                    for (int ks = 0; ks < KS; ++ks) sf[pt][ks] = *(const LAS bf16x8*)(Sc + (16 * pt + c) * QSTR + ks * 64 + quad * 16);
#pragma unroll
                for (int pt = 0; pt < 4; ++pt) ya[pt] = (f32x4){0.f, 0.f, 0.f, 0.f};
#pragma unroll
                for (int ks = 0; ks < KS; ++ks)
#pragma unroll
                    for (int pt = 0; pt < 4; ++pt) ya[pt] = MFMA16(sf[pt][ks], qf[ks], ya[pt]);
#pragma unroll
                for (int pt = 0; pt < 4; ++pt) ya[pt] = ya[pt] * ecum_i; }
            const int nkk = (itile >> 1) + 1;
#define RC_YSTEPS(NKK) do { \
            _Pragma("unroll") for (int kk = 0; kk < (NKK); ++kk) { \
                bf16x8 ka[2][KS]; \
                _Pragma("unroll") for (int half = 0; half < 2; ++half) \
                    _Pragma("unroll") for (int ks = 0; ks < KS; ++ks) ka[half][ks] = *(const LAS bf16x8*)(Kc + (32 * kk + 16 * half + c) * QSTR + ks * 64 + quad * 16); \
                f32x4 cj[2], sj[2]; \
                _Pragma("unroll") for (int half = 0; half < 2; ++half) { cj[half] = *(const LAS f32x4*)(CUM + 32 * kk + 16 * half + 4 * quad); sj[half] = *(const LAS f32x4*)(SJ + 32 * kk + 16 * half + 4 * quad); } \
                s16x4 vlo[4], vhi[4]; \
                _Pragma("unroll") for (int pt = 0; pt < 4; ++pt) { const LAS unsigned char* vp = Vc + (32 * kk + 4 * quad + q4) * VSTR + (16 * pt + 4 * p4) * 2; vlo[pt] = tr16(vp); vhi[pt] = tr16(vp + 16 * VSTR); } \
                f32x4 g0 = (f32x4){0.f, 0.f, 0.f, 0.f}, g1 = (f32x4){0.f, 0.f, 0.f, 0.f}; \
                _Pragma("unroll") for (int ks = 0; ks < KS; ++ks) { g0 = MFMA16(ka[0][ks], qf[ks], g0); g1 = MFMA16(ka[1][ks], qf[ks], g1); } \
                v4u w; \
                _Pragma("unroll") for (int half = 0; half < 2; ++half) { const f32x4 gacc = half ? g1 : g0; float pv[4]; \
                    _Pragma("unroll") for (int r = 0; r < 4; ++r) { const int j = 32 * kk + 16 * half + 4 * quad + r; const bool ok = rev ? (j < icol) : (j <= icol); \
                        const float e = __builtin_amdgcn_exp2f(fminf(cum_i - cj[half][r], 0.f)); pv[r] = ok ? gacc[r] * sj[half][r] * e : 0.f; } \
                    w[2 * half] = pk2(pv[0], pv[1]); w[2 * half + 1] = pk2(pv[2], pv[3]); } \
                const bf16x8 pfr = __builtin_bit_cast(bf16x8, w); \
                _Pragma("unroll") for (int pt = 0; pt < 4; ++pt) ya[pt] = MFMA16(CAT8(vlo[pt], vhi[pt]), pfr, ya[pt]); \
            } } while (0)
            if (nkk == 4) RC_YSTEPS(4); else if (nkk == 3) RC_YSTEPS(3); else if (nkk == 2) RC_YSTEPS(2); else RC_YSTEPS(1);
#undef RC_YSTEPS
            GAS bf16* yp = Ygg + (size_t)(sbase_ + pos0_ + pstep_ * icol) * ypitch + 4 * quad;
#pragma unroll
            for (int pt = 0; pt < 4; ++pt) { v2u w; w.x = pk2(ya[pt][0], ya[pt][1]); w.y = pk2(ya[pt][2], ya[pt][3]); *(GAS v2u*)(yp + 16 * pt) = w; }
        }
        if (ci + 1 < 18) { RC_STORE(cur ^ 1); RC_CUM(cur ^ 1);
#pragma unroll
            for (int ks = 0; ks < KS; ++ks) qf[ks] = qn[ks];
            if (ci + 2 < 18) RC_LOAD(ci + 2); }
        { const float dec = CUM[512];
#pragma unroll
          for (int i = 0; i < TPW; ++i) sacc[i] = sacc[i] * dec;
#pragma unroll
          for (int kk = 0; kk < 4; ++kk) {
              const LAS unsigned char* kp = Kc + (32 * kk + 8 * quad + q4) * QSTR + (16 * own_nt + 4 * p4) * 2;
              const s16x4 klo = tr16(kp), khi = tr16(kp + 4 * QSTR);
              const f32x4 w0 = *(const LAS f32x4*)(WJ + 32 * kk + 8 * quad), w1 = *(const LAS f32x4*)(WJ + 32 * kk + 8 * quad + 4);
              v4u kw; kw.x = pk2(bf1((bf16)klo[0]) * w0[0], bf1((bf16)klo[1]) * w0[1]); kw.y = pk2(bf1((bf16)klo[2]) * w0[2], bf1((bf16)klo[3]) * w0[3]);
              kw.z = pk2(bf1((bf16)khi[0]) * w1[0], bf1((bf16)khi[1]) * w1[1]); kw.w = pk2(bf1((bf16)khi[2]) * w1[2], bf1((bf16)khi[3]) * w1[3]);
              const bf16x8 kb = __builtin_bit_cast(bf16x8, kw);
#pragma unroll
              for (int i = 0; i < TPW; ++i) { const LAS unsigned char* vp = Vc + (32 * kk + 8 * quad + q4) * VSTR + (16 * (own_pt0 + i) + 4 * p4) * 2;
                  const s16x4 lo = tr16(vp), hi = tr16(vp + 4 * VSTR); sacc[i] = MFMA16(CAT8(lo, hi), kb, sacc[i]); }
          } }
#pragma unroll
        for (int i = 0; i < TPW; ++i)
#pragma unroll
            for (int r = 0; r < 4; ++r) *(LAS bf16*)(lds + OFF_S + (cur ^ 1) * SB_ + (16 * (own_pt0 + i) + 4 * quad + r) * QSTR + (16 * own_nt + c) * 2) = (bf16)f2bf(sacc[i][r]);
        __syncthreads();
    }
#undef RC_GEOM
#undef RC_LOAD
#undef RC_STORE
#undef RC_CUM
}
__device__ __forceinline__ void finish_rows(const Args& A, unsigned char* ws, int layer, int m0, int m1, int mstep, int lane) {
    const bf16* PROJ = (const bf16*)(ws + WS_BIG); const bf16* XBC2 = (const bf16*)(ws + WS_XBC2);
    bf16* MIXA = (bf16*)(ws + WS_XN);
    const int Mrows = layer == 0 ? MALL : MLAT;
    const bf16* Yret = (const bf16*)A.out; const bf16* Yssd = Yret + (size_t)2 * Mrows * 256;
    const f32x4 gg = *(const f32x4*)(A.in[12] + layer * 256 + 4 * lane), gb = *(const f32x4*)(A.in[13] + layer * 256 + 4 * lane);
    const int l8 = lane < 48 ? lane : 0;
    const float dsk = A.in[18][layer * 6 + (l8 >> 3)];
    const f32x4 ng0 = *(const f32x4*)(A.in[19] + layer * 384 + 8 * l8), ng1 = *(const f32x4*)(A.in[19] + layer * 384 + 8 * l8 + 4);
#pragma unroll 2
    for (int m = m0; m < m1; m += mstep) {
        {
            const v2u a = __builtin_nontemporal_load((const v2u*)(Yret + (size_t)m * 256 + 4 * lane)), bq = __builtin_nontemporal_load((const v2u*)(Yret + ((size_t)Mrows + m) * 256 + 4 * lane));
            const v2u gq = __builtin_nontemporal_load((const v2u*)(PROJ + (size_t)m * NPROJ + C_GR + 4 * lane));
            float y[4] = {bflo(a.x) + bflo(bq.x), bfhi(a.x) + bfhi(bq.x), bflo(a.y) + bflo(bq.y), bfhi(a.y) + bfhi(bq.y)};
            const float gv[4] = {bflo(gq.x), bfhi(gq.x), bflo(gq.y), bfhi(gq.y)};
            const float mu = sum16((y[0] + y[1]) + (y[2] + y[3])) * (1.f / 64.f);
            float d[4], q = 0.f;
#pragma unroll
            for (int e = 0; e < 4; ++e) { d[e] = y[e] - mu; q += d[e] * d[e]; }
            const float rstd = rsqrtf(sum16(q) * (1.f / 64.f) + EPS);
            float o[4];
#pragma unroll
            for (int e = 0; e < 4; ++e) o[e] = (d[e] * rstd * gg[e] + gb[e]) * silu_f(gv[e]);
            v2u w; w.x = pk2(o[0], o[1]); w.y = pk2(o[2], o[3]); st8_wt(MIXA + (size_t)m * DM + 384 + 4 * lane, w);
        }
        {
            float u[8]; float ss = 0.f;
            if (lane < 48) {
                const v4u a = __builtin_nontemporal_load((const v4u*)(Yssd + (size_t)m * 384 + 8 * lane)), bq = __builtin_nontemporal_load((const v4u*)(Yssd + ((size_t)Mrows + m) * 384 + 8 * lane));
                const v4u xs = __builtin_nontemporal_load((const v4u*)(XBC2 + (size_t)m * XBW + 8 * lane)), z = __builtin_nontemporal_load((const v4u*)(PROJ + (size_t)m * NPROJ + C_Z + 8 * lane));
#pragma unroll
                for (int e2 = 0; e2 < 4; ++e2) { const float y0 = bflo(a[e2]) + bflo(bq[e2]) + dsk * bflo(xs[e2]), y1 = bfhi(a[e2]) + bfhi(bq[e2]) + dsk * bfhi(xs[e2]);
                    u[2 * e2] = y0 * silu_f(bflo(z[e2])); u[2 * e2 + 1] = y1 * silu_f(bfhi(z[e2])); ss += u[2 * e2] * u[2 * e2] + u[2 * e2 + 1] * u[2 * e2 + 1]; }
            } else {
#pragma unroll
                for (int e = 0; e < 8; ++e) u[e] = 0.f;
            }
            const float rstd = rsqrtf(wave_sum(ss) * (1.f / 384.f) + EPS);
            if (lane < 48) { v4u w; w.x = pk2(u[0] * rstd * ng0[0], u[1] * rstd * ng0[1]); w.y = pk2(u[2] * rstd * ng0[2], u[3] * rstd * ng0[3]);
                w.z = pk2(u[4] * rstd * ng1[0], u[5] * rstd * ng1[1]); w.w = pk2(u[6] * rstd * ng1[2], u[7] * rstd * ng1[3]);
                st16_wt(MIXA + (size_t)m * DM + 640 + 8 * lane, w); }
        }
    }
}

constexpr int U_SSD = 96, U_RET = 64, U_ATT = 384, U_CATT = 48, FIN_ROWS = 32;
__device__ __forceinline__ void mixer_phase(Frame& F, const Args& A, int layer, int rep, unsigned gmask = 0xffu) {
    const bool ctx_out = layer == 0; const int Mrows = ctx_out ? MALL : MLAT;
    const int n_mix = U_SSD + U_RET + U_ATT + (ctx_out ? U_CATT : 0), total = n_mix + Mrows / FIN_ROWS;
    gu32* recdone = F.ctl + CW_FLAGS + 64 * 8 * (layer + 2 * rep);
    const int per_q = 12 + 8 + 48 + (ctx_out ? 6 : 0) + 64 + (ctx_out ? 8 : 0);
    gu32* qhead = F.ctl + CW_QUEUE + 64 * 8 * (layer + 2 * rep);
#define MIX_LIGHT (F.MISC[40] != 0u)
#define MIX_HOME ((int)blockIdx.x & 7)
#define MIX_HOMEFL (F.ctl + CW_FLAGS + 10752 + 64 * 8 * (layer + 2 * rep))
    int qi = MIX_HOME; bool scan = false; unsigned prep_mask = 0u, acq_mask = 0u;
    for (;;) {
        if (F.wave == 0) {
            int q = qi; bool none = false;
            if (scan) { const unsigned h = F.lane < 8 ? __hip_atomic_load(qhead + 64 * F.lane, RLX_AGENT) : 0xffffffffu;
                const unsigned fl = (F.lane < 8 && MIX_LIGHT && (int)F.lane != MIX_HOME) ? __hip_atomic_load(MIX_HOMEFL + 64 * F.lane, RLX_AGENT) : 1u;
                const unsigned mask = (unsigned)__ballot(F.lane < 8 && h < (unsigned)per_q && fl != 0u) & 0xffu;
                const unsigned rot = ((mask >> qi) | (mask << (8 - qi))) & 0xffu;
                if (rot == 0u) none = true; else q = (qi + __builtin_ctz(rot)) & 7; }
            if (F.lane == 0) { F.MISC[17] = (unsigned)q; F.MISC[16] = none ? 0xffffffffu : __hip_atomic_fetch_add(qhead + 64 * q, 1u, RLX_AGENT); }
        }
        __syncthreads();
        const unsigned idxu = F.MISC[16]; const int qsel = (int)F.MISC[17];
        __syncthreads();
        if (idxu == 0xffffffffu) break;
        qi = qsel;
        if ((int)idxu >= per_q) { scan = true; continue; }
        int uq;
        { int k = (int)idxu; const int bq = qi;
          if (k < 12) uq = bq * 12 + k; else { k -= 12;
          if (k < 8) uq = U_SSD + bq * 8 + k; else { k -= 8;
          if (k < 48) uq = U_SSD + U_RET + bq * 48 + k; else { k -= 48;
          if (ctx_out && k < 6) uq = U_SSD + U_RET + U_ATT + bq * 6 + k; else { if (ctx_out) k -= 6;
          if (k < 64) uq = n_mix + bq * 64 + k; else uq = n_mix + MLAT / FIN_ROWS + bq * 8 + (k - 64); } } } } }
#ifdef REP_ONLY_REC
        if (rep > 0 && (uq >= U_SSD + U_RET && uq < n_mix)) continue;
#endif
#ifdef REP_ONLY_ATT
        if (rep > 0 && (uq < U_SSD + U_RET || uq >= n_mix)) continue;
#endif
        if (uq >= total) break;
        int tid = F.tid; asm volatile("" : "+v"(tid));
        const int lane = tid & 63, wave = __builtin_amdgcn_readfirstlane(tid >> 6);
        unsigned char* wsb = A.ws; asm volatile("" : "+s"(wsb));
        const int u = uq;
        const bf16* PROJ = (const bf16*)(wsb + WS_BIG); const bf16* XBC2 = (const bf16*)(wsb + WS_XBC2); const float* DTLA = (const float*)(wsb + WS_DTLA);
        bf16* MIXA = (bf16*)(wsb + WS_XN);
        bf16* Yret = (bf16*)A.out; bf16* Yssd = Yret + (size_t)2 * Mrows * 256;
#define MIX_GEMM_WAIT(b_) do { if (!((gmask >> (b_)) & 1u)) { if (tid == 0) { unsigned sp_ = 0; \
                while (__hip_atomic_load(F.ctl + CW_FLAGS + 3072 + 64 * (8 * layer + (b_)), RLX_AGENT) < (unsigned)((MALL / 256 / 8) * (NPROJ / 256)) && ++sp_ < (1u << 24)) __builtin_amdgcn_s_sleep(2); \
                __builtin_amdgcn_fence(__ATOMIC_ACQUIRE, "agent"); asm volatile("s_waitcnt vmcnt(0)" ::: "memory"); } __syncthreads(); gmask |= 1u << (b_); } } while (0)
#define REC_PUBLISH(b_) do { asm volatile("s_waitcnt vmcnt(0)" ::: "memory"); __syncthreads(); \
            if (tid == 0) { __builtin_amdgcn_fence(__ATOMIC_RELEASE, "agent"); asm volatile("s_waitcnt vmcnt(0)" ::: "memory"); __hip_atomic_fetch_add(recdone + 64 * (b_), 1u, RLX_AGENT); \
                if (MIX_LIGHT) __hip_atomic_store(MIX_HOMEFL + 64 * MIX_HOME, 1u, RLX_AGENT); } } while (0)
        if (u >= n_mix) {
            const int row0 = (u - n_mix) * FIN_ROWS, b = row0 < MLAT ? row0 >> 11 : (row0 - MLAT) >> 8;
            if (!((acq_mask >> b) & 1u)) {
                if (tid == 0) { unsigned sp = 0; while (__hip_atomic_load(recdone + 64 * b, RLX_AGENT) < 20u && ++sp < (1u << 24)) __builtin_amdgcn_s_sleep(4);
                    __builtin_amdgcn_fence(__ATOMIC_ACQUIRE, "agent"); asm volatile("s_waitcnt vmcnt(0)" ::: "memory"); }
                __syncthreads();
                acq_mask |= 1u << b;
            }
            finish_rows(A, wsb, layer, row0 + wave, row0 + FIN_ROWS, NWAVES, lane);
            continue;
        }
        if (u < U_SSD) {
            const int b = u / 12, h = (u % 12) >> 1, dir = u & 1, g = h / 3;
            if (!((prep_mask >> b) & 1u)) {
                if (tid == 0) { const unsigned need = (unsigned)((F.G - b + 7) >> 3); unsigned sp = 0;
                    while (__hip_atomic_load(F.ctl + CW_FLAGS + 2048 + 64 * (8 * layer + b), RLX_AGENT) < need && ++sp < (1u << 24)) __builtin_amdgcn_s_sleep(2);
                    __builtin_amdgcn_fence(__ATOMIC_ACQUIRE, "agent"); asm volatile("s_waitcnt vmcnt(0)" ::: "memory"); }
                __syncthreads();
                prep_mask |= 1u << b;
            }
            rec_unit<128>(F.lds, tid, lane, wave, XBC2 + 640 + g * 128, XBC2 + 384 + g * 128, XBC2 + h * 64, XBW,
                          DTLA, dir * 6 + h, 12 + dir * 6 + h, 0.f, Yssd + (size_t)dir * Mrows * 384 + h * 64, 384, b, dir == 1, ctx_out);
            REC_PUBLISH(b);
        } else if (u < U_SSD + U_RET) {
            const int v = u - U_SSD, b = v >> 3, h = (v & 7) >> 1, dir = v & 1;
            MIX_GEMM_WAIT(b);
            const float dl = A.in[11][layer * 8 + dir * 4 + h];
            const float lg = fminf(dl, 0.f) - log1pf(expf(-fabsf(dl)));
            rec_unit<64>(F.lds, tid, lane, wave, PROJ + C_QR + h * 64, PROJ + C_KR + h * 64, PROJ + C_VR + h * 64, NPROJ,
                         nullptr, 0, 0, lg, Yret + (size_t)dir * Mrows * 256 + h * 64, 256, b, dir == 1, ctx_out);
            REC_PUBLISH(b);
        } else {
            const int v = u - U_SSD - U_RET; const bool isc = v >= U_ATT; const int vc = v - U_ATT;
            const int b = isc ? vc / 6 : v / 48, hq = isc ? vc % 6 : (v % 48) >> 3, qb = v & 7;
            MIX_GEMM_WAIT(b);
            attn_unit(F.lds, PROJ, MIXA, A.in[9] + layer * 64, A.in[10] + layer * 64, b, hq, isc ? MLAT + b * LCTX : b * SEQ + qb * 256, isc ? 16 : 0, isc ? 2 : 18, tid, lane, wave);
        }
    }
}
#ifndef PH_MASK
#define PH_MASK 0xFFFFF
#endif
#define IN(k) (((PH_MASK >> ((k) > 9 ? (k) - 9 : (k))) & 1) && lo <= (k) && (k) < hi)
#ifndef REP_X
#define REP_X 0
#endif
#ifndef REP_GSEL
#define REP_GSEL 0
#endif
#define MKFRAME() Frame F; { int t_ = threadIdx.x; asm volatile("" : "+v"(t_)); F.tid = t_; F.lane = t_ & 63; F.wave = __builtin_amdgcn_readfirstlane(t_ >> 6); F.lds = ldsb; \
    F.MISC = (volatile LAS unsigned*)(ldsb + MISC_OFF); F.ctl = (gu32*)(args.ws + WS_CTL); F.G = gridDim.x; const int bx_ = blockIdx.x; F.vcu = (F.G % 8 == 0) ? (bx_ % 8) * (F.G / 8) + bx_ / 8 : bx_; }
#define SEAM(k) do { if (IN((k) + 1)) xcd_barrier(bar); } while (0)
#define SEAM_LIGHT(k) do { if (IN((k) + 1)) xcd_barrier(bar, F.MISC[40] != 0u); } while (0)
#define CLSMASK(c_) ((gu32*)(args.ws + WS_CTL) + CW_FLAGS + 10240 + 64 * (c_))
#define NG (args.in[6] + (size_t)layer * 4 * DM)
#define MODL (MOD + (size_t)layer * 9 * 6144)
#define MOD ((float*)(args.ws + WS_MOD))
#define XN ((bf16*)(args.ws + WS_XN))
#define BIG ((bf16*)(args.ws + WS_BIG))
#define XC ((float*)(args.ws + WS_XC))
#define Win_t ((const bf16*)(args.ws + (layer == 0 ? WS_WIN : WS_WIN1)))
#define Wout_t ((const bf16*)(args.ws + WS_WOUT))
#define W1_t ((const bf16*)(args.ws + WS_W1))
#define W2_t ((const bf16*)(args.ws + WS_W2))
#define SLAB ((bf16*)args.out)
#define XB ((bf16*)(args.ws + WS_XB))
namespace pg8 {
struct HOrder {
    StaticOrder s; gu32* lat; gu32* ctx; mutable int k;
    __device__ bool next(int i, Unit& u) const { return s.next(i, u); }
    __device__ __forceinline__ void a_ready(const Unit&) const {}
    __device__ __forceinline__ void done(const Unit&) const {
        ++k; if (k < 4) return;
        asm volatile("s_waitcnt vmcnt(0)" ::: "memory"); __syncthreads();
        if (threadIdx.x == 0) { if (k == 4) __hip_atomic_fetch_add(lat, 4u, RLX_AGENT); else __hip_atomic_fetch_add(ctx, 1u, RLX_AGENT); }
    }
};
struct I0Order {
    StaticOrder s; int x, r, kslice; gu32* ctx; unsigned need; mutable bool ready;
    __device__ bool next(int i, Unit& u) const {
        if (i == 0) return s.next(0, u);
        if (r < 16 || i > 1) return false;
        const int idx = r - 16; u.pm = s.nM + x; u.pn = idx >> 2; u.ks = idx & 3; u.ko = u.ks * kslice; u.nkt = kslice / BK; return true;
    }
    __device__ __forceinline__ void a_ready(const Unit& u) const {
        if (u.ks < 0 || ready) return;
        if ((threadIdx.x & 63) == 0) { unsigned sp = 0; while (__hip_atomic_load(ctx, RLX_AGENT) < need && ++sp < (1u << 24)) __builtin_amdgcn_s_sleep(2); }
        __builtin_amdgcn_fence(__ATOMIC_ACQUIRE, "agent"); asm volatile("s_waitcnt vmcnt(0)" ::: "memory");
        ready = true;
    }
    __device__ __forceinline__ void done(const Unit&) const {}
};
}
template <int layer>
__device__ __forceinline__ void layer_body(LAS unsigned char* ldsb, const Args& args, const XcdBarrier& bar, const int lo, const int hi) {
        const int pb = 1 + 9 * layer; const int Mrows = layer == 0 ? MALL : MLAT;

        const bool bm = (gridDim.x % 8u) == 0u; unsigned gmask0 = bm ? 0u : 0xffu;
#define GEMMDONE(b_) (F.ctl + CW_FLAGS + 3072 + 64 * (8 * layer + (b_)))
#define HDONE(b_) (F.ctl + CW_FLAGS + 4096 + 64 * (8 * layer + (b_)))
#define HLAT(b_) (F.ctl + CW_FLAGS + 5120 + 64 * (b_))
#define HCTX(b_) (F.ctl + CW_FLAGS + 5632 + 64 * (b_))
#define WAIT_CNT(ptr_, need_) do { if (F.tid == 0) { unsigned sp_ = 0; while (__hip_atomic_load((ptr_), RLX_AGENT) < (need_) && ++sp_ < (1u << 24)) __builtin_amdgcn_s_sleep(2); \
            __builtin_amdgcn_fence(__ATOMIC_ACQUIRE, "agent"); asm volatile("s_waitcnt vmcnt(0)" ::: "memory"); } __syncthreads(); } while (0)
#define WAIT_CNT_RP(ptr_, need_) do { if (F.tid == 0) { unsigned sp_ = 0; while (__hip_atomic_load((ptr_), RLX_AGENT) < (need_) && ++sp_ < (1u << 24)) __builtin_amdgcn_s_sleep(2); \
            if (F.MISC[40] == 0u) { __builtin_amdgcn_fence(__ATOMIC_ACQUIRE, "agent"); asm volatile("s_waitcnt vmcnt(0)" ::: "memory"); } } __syncthreads(); } while (0)
#define FDONE(b_) (F.ctl + CW_FLAGS + 6144 + 64 * (8 * layer + (b_)))
#define IDONE_L(l_, b_) (F.ctl + CW_FLAGS + 7168 + 64 * (8 * (l_) + (b_)))
        const int cls = (int)blockIdx.x & 7, pgw = (((int)gridDim.x - cls + 7) >> 3) * NWAVES;
#define RRANGE(PM_) (bm ? RowRange{SEQ * cls + ((int)blockIdx.x >> 3) * NWAVES + F.wave, pgw, SEQ * cls + SEQ, MLAT + LCTX * cls + ((int)blockIdx.x >> 3) * NWAVES + F.wave, (PM_) > MLAT ? MLAT + LCTX * cls + LCTX : 0} \
                    : RowRange{F.vcu * NWAVES + F.wave, F.G * NWAVES, (PM_) < MLAT ? (PM_) : MLAT, MLAT + F.vcu * NWAVES + F.wave, (PM_)})
#define GEMM_UNITS_OF_WG(total_) (((total_) - (int)blockIdx.x + F.G - 1) / F.G)
#define PUBLISH_CNT(ptr_, n_) do { asm volatile("s_waitcnt vmcnt(0)" ::: "memory"); __syncthreads(); if (F.tid == 0) __hip_atomic_fetch_add((ptr_), (unsigned)(n_), RLX_AGENT); } while (0)
        if (IN(pb + 0)) { MKFRAME();
            RowPass P;
            if (layer == 0) P = RowPass{args.in[0], args.in[2], nullptr, nullptr, nullptr, XN, nullptr, nullptr, NG, MODL + 1024, MODL, MALL, nullptr};
            else { P = RowPass{XB, XC, XN, XB, nullptr, XN, MOD + 5120, args.in[6] + 3 * DM, NG, MODL + 1024, MODL, MALL, SLAB}; }
            if (layer == 1 && bm) WAIT_CNT_RP(IDONE_L(0, cls), 64u);
            row_pass<layer, 1, true, 4>(F, P, RRANGE(MALL));
#if (REP_X & 2)
            if (layer == 0) { xcd_barrier(bar); row_pass<layer, 1, true>(F, P, RRANGE(MALL)); }
#endif
            SEAM_LIGHT(pb + 0);
        }
        if (IN(pb + 1)) { MKFRAME();
            pg8::Gemm g{XN, Win_t, MALL, NPROJ, DM, DM}; pg8::StaticOrder S; S.init(MALL, NPROJ, F.G, (int)blockIdx.x, DM / 64); S.bmode = bm ? 1 : 0;
            fill_rope_table(F);
            EpiProj E{BIG, args.in[9] + layer * 64, args.in[10] + layer * 64, (const LAS float*)(F.lds + ROPE_LDS_OFF)};
            pg8::gemm_phase<EpiProj, pg8::StaticOrder, true, true>(F.lds + RING_OFF, g, S, E);
#if (REP_GSEL & 1)
            xcd_barrier(bar); pg8::gemm_phase<EpiProj, pg8::StaticOrder, true, true>(F.lds + RING_OFF, g, S, E);
#endif
            if (bm) {
                asm volatile("s_waitcnt vmcnt(0)" ::: "memory"); __syncthreads();
                if (F.tid == 0) { const int nun = ((MALL / 256) * (NPROJ / 256) - (int)blockIdx.x + F.G - 1) / F.G; __hip_atomic_fetch_add(GEMMDONE((int)blockIdx.x & 7), (unsigned)nun, RLX_AGENT); }
            }
            convert_weights(F, args, layer, 1);
            if constexpr (layer == 0) convert_weights(F, args, 1, 2);
            if (!bm) SEAM(pb + 1);
        }
        if (IN(pb + 2)) { MKFRAME();
            const int pbat = (int)blockIdx.x & 7, prank = (int)blockIdx.x >> 3, pgrp = (F.G - pbat + 7) >> 3;
            if (bm) { WAIT_CNT(GEMMDONE(pbat), (unsigned)((MALL / 256 / 8) * (NPROJ / 256))); gmask0 = 1u << pbat; }
            prep_rows(args, args.ws, layer, pbat * SEQ, SEQ, MLAT + pbat * LCTX, LCTX, prank * (NWAVES * 64) + F.tid, pgrp * NWAVES * 64);
            asm volatile("s_waitcnt vmcnt(0)" ::: "memory"); __syncthreads();
            if (F.tid == 0) __hip_atomic_fetch_add(F.ctl + CW_FLAGS + 2048 + 64 * (8 * layer + pbat), 1u, RLX_AGENT);
        }
        if (IN(pb + 3)) { MKFRAME(); mixer_phase(F, args, layer, 0, gmask0);
#ifdef REP_D
            for (int rep = 1; rep <= REP_D; ++rep) { xcd_barrier(bar); mixer_phase(F, args, layer, rep); }
#endif
            if (IN(pb + 5)) xcd_barrier(bar); }
        if (IN(pb + 5)) { MKFRAME();
            pg8::Gemm g{XN, Wout_t, Mrows, DM, DM, DM}; pg8::StaticOrder S; S.init(MLAT, DM, F.G, (int)blockIdx.x, DM / 64); S.bmode = bm ? 2 : 0;
            pg8::EpiStore<0> E{BIG, DM, SLAB, (size_t)MCTX * DM, MLAT};
            if constexpr (layer == 0) {
                pg8::SplitKOrder K; K.init(MLAT / 256, MCTX / 256, DM / 256, 8, DM / 8, F.G, (int)blockIdx.x); pg8::ComboOrder C; C.init(S, K);
                pg8::gemm_phase<pg8::EpiStore<0>, pg8::ComboOrder, true, true>(F.lds + RING_OFF, g, C, E);
            } else pg8::gemm_phase<pg8::EpiStore<0>, pg8::StaticOrder, true, true>(F.lds + RING_OFF, g, S, E);
#if (REP_GSEL & 2)
            xcd_barrier(bar); if constexpr (layer == 0) {
                pg8::SplitKOrder K; K.init(MLAT / 256, MCTX / 256, DM / 256, 8, DM / 8, F.G, (int)blockIdx.x); pg8::ComboOrder C; C.init(S, K);
                pg8::gemm_phase<pg8::EpiStore<0>, pg8::ComboOrder, true, true>(F.lds + RING_OFF, g, C, E);
            } else pg8::gemm_phase<pg8::EpiStore<0>, pg8::StaticOrder, true, true>(F.lds + RING_OFF, g, S, E);
#endif
            if (bm) PUBLISH_CNT(FDONE(cls), (layer == 0 ? 2 : 1) * GEMM_UNITS_OF_WG(256)); else SEAM(pb + 5);
        }
        if (IN(pb + 6)) { MKFRAME();
            RowPass P{layer == 0 ? (const void*)args.in[0] : (const void*)XB, layer == 0 ? args.in[2] : XC, BIG, XB, layer == 0 ? XC : nullptr, XN, MODL + 2048, NG + DM, NG + 2 * DM, MODL + 4096, MODL + 3072, Mrows, layer == 0 ? SLAB : nullptr};
            if (bm) WAIT_CNT_RP(FDONE(cls), layer == 0 ? 64u : 32u);
            row_pass<layer, 1>(F, P, RRANGE(Mrows));
#if (REP_X & 8)
            if (layer == 0) { xcd_barrier(bar); row_pass<layer, 1>(F, P, RRANGE(Mrows)); }
#endif
            SEAM_LIGHT(pb + 6);
        }
        if (IN(pb + 7)) { MKFRAME();
            pg8::Gemm g{XN, W1_t, Mrows, DFF, DM, DM}; pg8::StaticOrder S; S.init(Mrows, DFF, F.G, (int)blockIdx.x, DM / 64); S.bmode = bm ? (layer == 0 ? 1 : 2) : 0;
            pg8::EpiStore<2> E{BIG, DFF, nullptr, 0, 0};
            const bool hsplit = layer == 0 && F.G == 256;
            if (hsplit) { pg8::HOrder HO; HO.s = S; HO.lat = HLAT(cls); HO.ctx = HCTX(cls); HO.k = 0;
                pg8::gemm_phase<pg8::EpiStore<2>, pg8::HOrder, true, true>(F.lds + RING_OFF, g, HO, E);
            } else pg8::gemm_phase<pg8::EpiStore<2>, pg8::StaticOrder, true, true>(F.lds + RING_OFF, g, S, E);
            if (bm && !hsplit) {
                asm volatile("s_waitcnt vmcnt(0)" ::: "memory"); __syncthreads();
                if (F.tid == 0) { const int nun = ((Mrows / 256) * (DFF / 256) - (int)blockIdx.x + F.G - 1) / F.G; __hip_atomic_fetch_add(HDONE((int)blockIdx.x & 7), (unsigned)nun, RLX_AGENT); }
            }
#if (REP_GSEL & 4)
            xcd_barrier(bar); pg8::gemm_phase<pg8::EpiStore<2>, pg8::StaticOrder, true, true>(F.lds + RING_OFF, g, S, E);
#endif
            if (!bm) SEAM(pb + 7);
        }
        if (IN(pb + 8)) { MKFRAME();
            pg8::Gemm g{BIG, W2_t, Mrows, DM, DFF, DFF}; pg8::StaticOrder S; S.init(MLAT, DM, F.G, (int)blockIdx.x, DFF / 64); S.bmode = bm ? 2 : 0;
            pg8::EpiStore<0> E{XN, DM, SLAB, (size_t)MCTX * DM, MLAT};
            const bool hsplit = layer == 0 && F.G == 256;
            if (hsplit) WAIT_CNT(HLAT(cls), 128u);
            else if (bm) WAIT_CNT(HDONE((int)blockIdx.x & 7), (unsigned)((Mrows / 256 / 8) * (DFF / 256)));
            if constexpr (layer == 0) {
                if (hsplit) { pg8::I0Order IO; IO.s = S; IO.x = cls; IO.r = (int)blockIdx.x >> 3; IO.kslice = DFF / 4; IO.ctx = HCTX(cls); IO.need = 16u; IO.ready = false;
                    pg8::gemm_phase<pg8::EpiStore<0>, pg8::I0Order, true, true>(F.lds + RING_OFF, g, IO, E);
                } else { pg8::SplitKOrder K; K.init(MLAT / 256, MCTX / 256, DM / 256, 4, DFF / 4, F.G, (int)blockIdx.x); pg8::ComboOrder C; C.init(S, K);
                    pg8::gemm_phase<pg8::EpiStore<0>, pg8::ComboOrder, true, true>(F.lds + RING_OFF, g, C, E); }
            } else pg8::gemm_phase<pg8::EpiStore<0>, pg8::StaticOrder, true, true>(F.lds + RING_OFF, g, S, E);
#if (REP_GSEL & 8)
            xcd_barrier(bar); if constexpr (layer == 0) {
                pg8::SplitKOrder K; K.init(MLAT / 256, MCTX / 256, DM / 256, 8, DFF / 8, F.G, (int)blockIdx.x); pg8::ComboOrder C; C.init(S, K);
                pg8::gemm_phase<pg8::EpiStore<0>, pg8::ComboOrder, true, true>(F.lds + RING_OFF, g, C, E);
            } else pg8::gemm_phase<pg8::EpiStore<0>, pg8::StaticOrder, true, true>(F.lds + RING_OFF, g, S, E);
#endif
            if (bm) PUBLISH_CNT(IDONE_L(layer, cls), (layer == 0 ? 2 : 1) * GEMM_UNITS_OF_WG(256)); else SEAM(pb + 8);
        }
    }
__global__ void __launch_bounds__(NWAVES * 64, 2) fwd_kernel(Args args) {
    extern __shared__ __attribute__((aligned(16))) unsigned char lds[];
    LAS unsigned char* ldsb = (LAS unsigned char*)lds;
    for (int u = threadIdx.x; u < (LDS_BYTES - LDSCTL_OFF) / 4; u += NWAVES * 64) ((LAS unsigned*)(ldsb + LDSCTL_OFF))[u] = 0u;
    __syncthreads();
    XcdBarrier bar; bar.bar = (unsigned*)((gu32*)(args.ws + WS_CTL) + CW_BAR); bar.x = 0; bar.st = nullptr;
    if (!MK_PER_PHASE) bar = xcd_barrier_post((unsigned*)((gu32*)(args.ws + WS_CTL) + CW_BAR), (volatile LAS unsigned*)(ldsb + MISC_OFF) + 8);
    if (!MK_PER_PHASE && threadIdx.x == 0) (void)__hip_atomic_fetch_or(CLSMASK((int)blockIdx.x & 7), 1u << (bar.x & 15u), RLX_AGENT);
    const int lo = args.ph_lo, hi = args.ph_hi;

    if (IN(0)) { MKFRAME(); mod_phase(F, args); convert_weights(F, args, 0, 0);
        SEAM(0);
        if (!MK_PER_PHASE && (gridDim.x % 8u) == 0u) {
            if (F.wave == 0) { const unsigned m = F.lane < 8 ? __hip_atomic_load(CLSMASK(F.lane), RLX_AGENT) : 1u; const bool ok = __popc(m) == 1;
                const bool all1 = __all(ok); if (F.lane == 0) F.MISC[40] = all1 ? 1u : 0u; }
            __syncthreads();
        } }
    layer_body<0>(ldsb, args, bar, lo, hi);
    layer_body<1>(ldsb, args, bar, lo, hi);
#ifdef REP_BAR
    for (int rb = 0; rb < REP_BAR; ++rb) xcd_barrier(bar);
#endif
    if (IN(19)) { MKFRAME();
        RowPass P{XB, XC, XN, args.out, nullptr, nullptr, MOD + 9 * 6144 + 5120, args.in[6] + 7 * DM, nullptr, nullptr, nullptr, MLAT, nullptr};
        const bool bm = (gridDim.x % 8u) == 0u; const int cls = (int)blockIdx.x & 7, pgw = (((int)gridDim.x - cls + 7) >> 3) * NWAVES;
        if (bm) WAIT_CNT_RP(IDONE_L(1, cls), 32u);
        row_pass<1, 0>(F, P, RRANGE(MLAT));
    }
}

extern "C" void kernel_launch(void* const* d_in, const int* in_sizes, int n_in, void* d_out, int out_size, void* d_ws, size_t ws_size, hipStream_t stream) {
    static int grid = 0;
    if (grid == 0) {
        if (n_in != 22 || in_sizes[0] != MLAT * DM || out_size != MLAT * DM || ws_size < WS_END) {
            fprintf(stderr, "kernel_launch: unexpected shapes: n_in %d in0 %d out %d ws %zu; nothing launched\n", n_in, n_in > 0 ? in_sizes[0] : -1, out_size, ws_size); grid = -1; return; }
        int dev = 0, cus = 0, per_cu = 0;
        if (hipGetDevice(&dev) != hipSuccess || hipDeviceGetAttribute(&cus, hipDeviceAttributeMultiprocessorCount, dev) != hipSuccess) { grid = -1; return; }
        if (hipFuncSetAttribute((const void*)fwd_kernel, hipFuncAttributeMaxDynamicSharedMemorySize, LDS_BYTES) != hipSuccess) { fprintf(stderr, "kernel_launch: hipFuncSetAttribute failed\n"); grid = -1; return; }
        if (hipOccupancyMaxActiveBlocksPerMultiprocessor(&per_cu, (const void*)fwd_kernel, NWAVES * 64, LDS_BYTES) != hipSuccess || per_cu < 1)
            fprintf(stderr, "kernel_launch: note: occupancy query reports %d workgroups per CU\n", per_cu);
        (void)hipGetLastError();
        grid = cus;
    }
    if (grid < 0) return;
    if (hipMemsetAsync((char*)d_ws + WS_CTL, 0, CTL_ZERO_BYTES, stream) != hipSuccess) { fprintf(stderr, "kernel_launch: memset failed\n"); return; }
    Args a{};
    for (int i = 0; i < 22; ++i) a.in[i] = (const float*)d_in[i];
    a.out = (float*)d_out; a.ws = (unsigned char*)d_ws;
#if MK_PER_PHASE
    for (int ph = 0; ph < N_PHASES; ++ph) { a.ph_lo = ph; a.ph_hi = ph + 1; a.li = ph;
        hipLaunchKernelGGL(fwd_kernel, dim3(grid), dim3(NWAVES * 64), LDS_BYTES, stream, a); }
#else
    a.ph_lo = 0; a.ph_hi = N_PHASES; a.li = 0;
    hipLaunchKernelGGL(fwd_kernel, dim3(grid), dim3(NWAVES * 64), LDS_BYTES, stream, a);
#endif
    const hipError_t le = hipPeekAtLastError();
    if (le != hipSuccess) fprintf(stderr, "kernel_launch: launch failed: %s\n", hipGetErrorName(le));
}
```
